# Optimizing an MI355X kernel written in HIP

```python
import jax
import jax.numpy as jnp
from jax import lax
import numpy as np

D_MODEL = 4096
BATCH = 4
SEQ = 2048
DEPTH = 1

HEAD_DIM = 128
NSA_HEADS = 16
NSA_KV_GROUPS = 4
NSA_Q_PER_KV = NSA_HEADS // NSA_KV_GROUPS
FOX_HEADS = 16
NSA_WIDTH = NSA_HEADS * HEAD_DIM
FOX_WIDTH = FOX_HEADS * HEAD_DIM
N_NSA_BRANCHES = 3
N_MERGE_BRANCHES = 2
CMP_BLOCK = 32
CMP_STRIDE = 16
SEL_BLOCK = 64
SEL_TOPN = 16
WINDOW = 512
Q_BLOCK = 128
SEL_Q_BLOCK = 16
ROPE_THETA = 500000.0
ROT_DIM = HEAD_DIM // 4
D_FF = 4 * D_MODEL
RMS_EPS = 1e-6
ATTN_SCALE = HEAD_DIM ** -0.5

COLS_NSA_Q = NSA_WIDTH
COLS_NSA_KV = N_NSA_BRANCHES * 2 * NSA_KV_GROUPS * HEAD_DIM
COLS_NSA_GATE = N_NSA_BRANCHES * NSA_HEADS
COLS_FOX_QKV = 3 * FOX_WIDTH
COLS_FOX_F = FOX_HEADS
COLS_MERGE = N_MERGE_BRANCHES * D_MODEL
D_IN = COLS_NSA_Q + COLS_NSA_KV + COLS_NSA_GATE + COLS_FOX_QKV + COLS_FOX_F + COLS_MERGE
SPLIT_POINTS = [COLS_NSA_Q,
                COLS_NSA_Q + COLS_NSA_KV,
                COLS_NSA_Q + COLS_NSA_KV + COLS_NSA_GATE,
                COLS_NSA_Q + COLS_NSA_KV + COLS_NSA_GATE + COLS_FOX_QKV,
                COLS_NSA_Q + COLS_NSA_KV + COLS_NSA_GATE + COLS_FOX_QKV + COLS_FOX_F]

kernel_name = "hybrid_nsa_fox_gated_block"


def _rmsnorm(x, g):
    xf = x.astype(jnp.float32)
    y = xf * lax.rsqrt(jnp.mean(xf * xf, axis=-1, keepdims=True) + RMS_EPS)
    return (y * g.astype(jnp.float32)).astype(x.dtype)


def _partial_rope(x, pos):
    half = ROT_DIM // 2
    inv = ROPE_THETA ** (-jnp.arange(half, dtype=jnp.float32) / half)
    ang = jnp.asarray(pos, dtype=jnp.float32)[:, None] * inv[None, :]
    cos = jnp.cos(ang)[:, None, :].astype(x.dtype)
    sin = jnp.sin(ang)[:, None, :].astype(x.dtype)
    x1 = x[..., :half]
    x2 = x[..., half:ROT_DIM]
    return jnp.concatenate([x1 * cos - x2 * sin, x1 * sin + x2 * cos, x[..., ROT_DIM:]], axis=-1)


def _masked_softmax(s, mask):
    s = jnp.where(mask, s.astype(jnp.float32), -jnp.inf)
    m = jnp.max(s, axis=-1, keepdims=True)
    m = jnp.where(jnp.isfinite(m), m, 0.0)
    p = jnp.exp(s - m)
    d = jnp.sum(p, axis=-1, keepdims=True)
    return p / jnp.where(d > 0, d, 1.0)


def _compress(x, pos_emb, w1, w2):
    B, T, G, dh = x.shape
    n_cmp = (T - CMP_BLOCK) // CMP_STRIDE + 1
    idx = np.arange(n_cmp)[:, None] * CMP_STRIDE + np.arange(CMP_BLOCK)[None, :]
    blocks = x[:, idx] + pos_emb[None, None, :, None, :]
    blocks = blocks.transpose(0, 1, 3, 2, 4).reshape(B, n_cmp, G, CMP_BLOCK * dh)
    return jax.nn.gelu(blocks @ w1) @ w2


def _nsa(q, kv, gate_logits, nsa_k_norm, cmp_pos_k, cmp_pos_v, w_cmp_k1, w_cmp_k2, w_cmp_v1, w_cmp_v2):
    B, T, H, dh = q.shape
    G, R = NSA_KV_GROUPS, NSA_Q_PER_KV
    pos = np.arange(T)
    q_g = q.reshape(B, T, G, R, dh)
    kc, vc = kv[:, :, 0, 0], kv[:, :, 0, 1]
    ks = _partial_rope(_rmsnorm(kv[:, :, 1, 0], nsa_k_norm), pos)
    vs = kv[:, :, 1, 1]
    kw = _partial_rope(_rmsnorm(kv[:, :, 2, 0], nsa_k_norm), pos)
    vw = kv[:, :, 2, 1]

    n_cmp = (T - CMP_BLOCK) // CMP_STRIDE + 1
    end_pos = np.arange(n_cmp) * CMP_STRIDE + CMP_BLOCK - 1
    k_cmp = _compress(kc, cmp_pos_k, w_cmp_k1, w_cmp_k2)
    k_cmp = _partial_rope(_rmsnorm(k_cmp, nsa_k_norm), end_pos)
    v_cmp = _compress(vc, cmp_pos_v, w_cmp_v1, w_cmp_v2)
    s_c = jnp.einsum('btgrd,bngd->bgrtn', q_g, k_cmp) * ATTN_SCALE
    p_c = _masked_softmax(s_c, end_pos[None, :] <= pos[:, None])
    o_c = jnp.einsum('bgrtn,bngd->btgrd', p_c.astype(v_cmp.dtype), v_cmp)

    n_slc = T // SEL_BLOCK
    ci = np.arange(n_cmp)[:, None] * CMP_STRIDE
    sj = np.arange(n_slc)[None, :] * SEL_BLOCK
    overlap = ((ci < sj + SEL_BLOCK) & (ci + CMP_BLOCK > sj)).astype(np.float32)
    imp = jnp.einsum('bgtn,nj->bgtj', jnp.sum(p_c, axis=2), overlap)
    cur = pos // SEL_BLOCK
    jj = np.arange(n_slc)
    forced = (jj[None, :] == 0) | (jj[None, :] == cur[:, None]) | (jj[None, :] == cur[:, None] - 1)
    causal = jj[None, :] <= cur[:, None]
    score = jnp.where(forced, jnp.inf, jnp.where(causal, imp, -jnp.inf))
    top_n = min(SEL_TOPN, n_slc)
    sel_val, sel_idx = lax.top_k(score, top_n)
    sel_ok = sel_val > -jnp.inf

    kb = ks.reshape(B, n_slc, SEL_BLOCK, G, dh).transpose(0, 3, 1, 2, 4)
    vb = vs.reshape(B, n_slc, SEL_BLOCK, G, dh).transpose(0, 3, 1, 2, 4)
    nb = T // SEL_Q_BLOCK
    bi = jnp.arange(B)[:, None, None, None]
    gi = jnp.arange(G)[None, :, None, None]

    def sel_block(args):
        cblk, qb, ib, okb = args
        kg = kb[bi, gi, ib]
        vg = vb[bi, gi, ib]
        tq = cblk * SEL_Q_BLOCK + jnp.arange(SEL_Q_BLOCK)
        kpos = ib[..., None] * SEL_BLOCK + jnp.arange(SEL_BLOCK)
        mask = okb[..., None] & (kpos <= tq[None, None, :, None, None])
        s = jnp.einsum('bqgrd,bgqnld->bgrqnl', qb, kg) * ATTN_SCALE
        s = s.reshape(B, G, R, SEL_Q_BLOCK, top_n * SEL_BLOCK)
        p = _masked_softmax(s, mask.reshape(B, G, 1, SEL_Q_BLOCK, top_n * SEL_BLOCK))
        p = p.reshape(B, G, R, SEL_Q_BLOCK, top_n, SEL_BLOCK).astype(vg.dtype)
        return jnp.einsum('bgrqnl,bgqnld->bqgrd', p, vg)

    xs_sel = (jnp.arange(nb),
              q_g.reshape(B, nb, SEL_Q_BLOCK, G, R, dh).swapaxes(0, 1),
              sel_idx.reshape(B, G, nb, SEL_Q_BLOCK, top_n).transpose(2, 0, 1, 3, 4),
              sel_ok.reshape(B, G, nb, SEL_Q_BLOCK, top_n).transpose(2, 0, 1, 3, 4))
    o_s = lax.map(sel_block, xs_sel).swapaxes(0, 1).reshape(B, T, G, R, dh)

    kpad = jnp.pad(kw, ((0, 0), (WINDOW, 0), (0, 0), (0, 0)))
    vpad = jnp.pad(vw, ((0, 0), (WINDOW, 0), (0, 0), (0, 0)))
    nq = T // Q_BLOCK
    span = WINDOW + Q_BLOCK

    def win_block(args):
        cblk, qb = args
        start = cblk * Q_BLOCK
        kband = lax.dynamic_slice_in_dim(kpad, start, span, axis=1)
        vband = lax.dynamic_slice_in_dim(vpad, start, span, axis=1)
        tq = start + jnp.arange(Q_BLOCK)
        kpos = start - WINDOW + jnp.arange(span)
        mask = (kpos[None, :] <= tq[:, None]) & (kpos[None, :] > tq[:, None] - WINDOW) & (kpos[None, :] >= 0)
        s = jnp.einsum('bqgrd,bkgd->bgrqk', qb, kband) * ATTN_SCALE
        p = _masked_softmax(s, mask).astype(vband.dtype)
        return jnp.einsum('bgrqk,bkgd->bqgrd', p, vband)

    xs_win = (jnp.arange(nq), q_g.reshape(B, nq, Q_BLOCK, G, R, dh).swapaxes(0, 1))
    o_w = lax.map(win_block, xs_win).swapaxes(0, 1).reshape(B, T, G, R, dh)

    g = jax.nn.sigmoid(gate_logits).reshape(B, T, G, R, N_NSA_BRANCHES)
    o = g[..., 0:1] * o_c + g[..., 1:2] * o_s + g[..., 2:3] * o_w
    return o.reshape(B, T, NSA_WIDTH)


def _fox(q, k, v, f_logit):
    B, T, H, dh = q.shape
    cum = jnp.cumsum(jax.nn.log_sigmoid(f_logit.astype(jnp.float32)), axis=1).transpose(0, 2, 1)
    outs = []
    for i in range(T // Q_BLOCK):
        qs, qe = i * Q_BLOCK, (i + 1) * Q_BLOCK
        s = jnp.einsum('bqhd,bkhd->bhqk', q[:, qs:qe], k[:, :qe]).astype(jnp.float32) * ATTN_SCALE
        bias = cum[:, :, qs:qe, None] - cum[:, :, None, :qe]
        mask = np.arange(qs, qe)[:, None] >= np.arange(qe)[None, :]
        p = _masked_softmax(s + bias, mask).astype(v.dtype)
        outs.append(jnp.einsum('bhqk,bkhd->bqhd', p, v[:, :qe]))
    return jnp.concatenate(outs, axis=1).reshape(B, T, FOX_WIDTH)


def setup_inputs(seed: int = 0) -> dict:
    key = jax.random.key(seed)
    ks = jax.random.split(key, 24)
    f32 = jnp.float32
    L = DEPTH

    def nrm(k, shape, fan_in, mult=1.0):
        return jax.random.normal(k, shape, f32) * (mult * fan_in ** -0.5)

    def gain(k, shape):
        return 1.0 + 0.02 * jax.random.normal(k, shape, f32)

    return {
        "x": jax.random.normal(ks[0], (BATCH, SEQ, D_MODEL), f32),
        "c": jax.random.normal(ks[1], (BATCH, D_MODEL), f32),
        "w_ada": nrm(ks[2], (L, D_MODEL, 6 * D_MODEL), D_MODEL, 0.5),
        "b_ada": 0.01 * jax.random.normal(ks[3], (L, 6 * D_MODEL), f32),
        "norm1_g": gain(ks[4], (L, D_MODEL)),
        "norm2_g": gain(ks[5], (L, D_MODEL)),
        "w_in": nrm(ks[6], (L, D_MODEL, D_IN), D_MODEL),
        "b_forget": jax.random.uniform(ks[7], (L, FOX_HEADS), f32, 1.0, 4.0),
        "nsa_q_norm": gain(ks[8], (L, HEAD_DIM)),
        "nsa_k_norm": gain(ks[9], (L, HEAD_DIM)),
        "fox_q_norm": gain(ks[10], (L, HEAD_DIM)),
        "fox_k_norm": gain(ks[11], (L, HEAD_DIM)),
        "cmp_pos_k": 0.1 * jax.random.normal(ks[12], (L, CMP_BLOCK, HEAD_DIM), f32),
        "cmp_pos_v": 0.1 * jax.random.normal(ks[13], (L, CMP_BLOCK, HEAD_DIM), f32),
        "w_cmp_k1": nrm(ks[14], (L, CMP_BLOCK * HEAD_DIM, HEAD_DIM), CMP_BLOCK * HEAD_DIM),
        "w_cmp_k2": nrm(ks[15], (L, HEAD_DIM, HEAD_DIM), HEAD_DIM),
        "w_cmp_v1": nrm(ks[16], (L, CMP_BLOCK * HEAD_DIM, HEAD_DIM), CMP_BLOCK * HEAD_DIM),
        "w_cmp_v2": nrm(ks[17], (L, HEAD_DIM, HEAD_DIM), HEAD_DIM),
        "w_up_nsa": nrm(ks[18], (L, NSA_WIDTH, D_MODEL), NSA_WIDTH),
        "w_up_fox": nrm(ks[19], (L, FOX_WIDTH, D_MODEL), FOX_WIDTH),
        "w_out": nrm(ks[20], (L, D_MODEL, D_MODEL), D_MODEL),
        "w_ff1": nrm(ks[21], (L, D_MODEL, D_FF), D_MODEL),
        "w_ff2": nrm(ks[22], (L, D_FF, D_MODEL), D_FF),
    }


def reference(x, c, w_ada, b_ada, norm1_g, norm2_g, w_in, b_forget, nsa_q_norm, nsa_k_norm,
              fox_q_norm, fox_k_norm, cmp_pos_k, cmp_pos_v, w_cmp_k1, w_cmp_k2, w_cmp_v1, w_cmp_v2,
              w_up_nsa, w_up_fox, w_out, w_ff1, w_ff2):
    B, T, D = x.shape
    pos = np.arange(T)
    for l in range(DEPTH):
        mod = jax.nn.silu(c) @ w_ada[l] + b_ada[l]
        shift1, scale1, gate1, shift2, scale2, gate2 = [m[:, None, :] for m in jnp.split(mod, 6, axis=-1)]

        h = _rmsnorm(x, norm1_g[l]) * (1.0 + scale1) + shift1
        proj = h @ w_in[l]
        nsa_q, nsa_kv, nsa_gate, fox_qkv, fox_f, merge_g = jnp.split(proj, SPLIT_POINTS, axis=-1)

        q_n = _partial_rope(_rmsnorm(nsa_q.reshape(B, T, NSA_HEADS, HEAD_DIM), nsa_q_norm[l]), pos)
        kv_n = nsa_kv.reshape(B, T, N_NSA_BRANCHES, 2, NSA_KV_GROUPS, HEAD_DIM)
        o_nsa = _nsa(q_n, kv_n, nsa_gate, nsa_k_norm[l], cmp_pos_k[l], cmp_pos_v[l],
                     w_cmp_k1[l], w_cmp_k2[l], w_cmp_v1[l], w_cmp_v2[l])

        qkv_f = fox_qkv.reshape(B, T, 3, FOX_HEADS, HEAD_DIM)
        q_f = _rmsnorm(qkv_f[:, :, 0], fox_q_norm[l])
        k_f = _rmsnorm(qkv_f[:, :, 1], fox_k_norm[l])
        o_fox = _fox(q_f, k_f, qkv_f[:, :, 2], fox_f + b_forget[l])

        g_merge = jax.nn.sigmoid(merge_g)
        y = g_merge[..., :D] * (o_nsa @ w_up_nsa[l]) + g_merge[..., D:] * (o_fox @ w_up_fox[l])
        x = x + gate1 * (y @ w_out[l])

        h2 = _rmsnorm(x, norm2_g[l]) * (1.0 + scale2) + shift2
        x = x + gate2 * (jnp.square(jax.nn.relu(h2 @ w_ff1[l])) @ w_ff2[l])
    return x
```

```cpp
#include <hip/hip_runtime.h>
#include <stdint.h>
#include <stdio.h>

typedef unsigned short bf16_t;
typedef float f32x4 __attribute__((ext_vector_type(4)));
typedef unsigned u32x4 __attribute__((ext_vector_type(4)));
typedef unsigned u32x2 __attribute__((ext_vector_type(2)));

constexpr int BATCH = 4, SEQ = 2048, DM = 4096, M = BATCH * SEQ;
constexpr int HD = 128, NH = 16, NG = 4, DFF = 16384;
constexpr int NCMP = 127;
constexpr float ATT_SCALE = 0.08838834764831845f;
constexpr float RMS_EPS = 1e-6f;
constexpr int PITCH = 19712, N_IN = 19520, N_IN_OLD = 19520;
constexpr int C_NSAQ = 0, C_NSAKV = 2048, C_FOX = 5120, C_MERGE = 11264, C_SMALL = 19456;
constexpr int C_KC = C_NSAKV + 0 * 128 * 4, C_VC = C_NSAKV + 1 * 512, C_KS = C_NSAKV + 2 * 512, C_VS = C_NSAKV + 3 * 512, C_KW = C_NSAKV + 4 * 512, C_VW = C_NSAKV + 5 * 512;
constexpr int C_FQ = C_FOX, C_FK = C_FOX + 2048, C_FV = C_FOX + 4096;
constexpr int C_GA = C_MERGE, C_GB = C_MERGE + 4096;

constexpr size_t KiB = 1024, MiB = 1024 * 1024;
constexpr size_t WS_CTL = 0, WS_ZERO_BYTES = 1 * MiB;
constexpr size_t WS_MOD = 256 * KiB;
constexpr size_t WS_C1 = 640 * KiB;
constexpr size_t WS_SS = 704 * KiB;
constexpr size_t WS_CB = 768 * KiB;
constexpr size_t WS_ROPE = 1 * MiB;
constexpr size_t WS_SMALL = 2 * MiB;
constexpr size_t WS_CUM = 4 * MiB;
constexpr size_t WS_KCMP = 5 * MiB, WS_VCMP = 5 * MiB + 512 * KiB;
constexpr size_t WS_WC2K_T = 1 * MiB + 512 * KiB, WS_WC2V_T = 1 * MiB + 576 * KiB;
constexpr size_t WS_WC1K_T = 6 * MiB, WS_WC1V_T = 7 * MiB;
constexpr size_t WS_H = 8 * MiB;
constexpr size_t WS_ONSA = 72 * MiB, WS_OFOX = 104 * MiB;
constexpr size_t WS_Y = 136 * MiB;
constexpr size_t WS_PROJ = 200 * MiB;
constexpr size_t WS_A = WS_PROJ;
constexpr size_t WS_END = 992 * MiB;

__device__ __forceinline__ float bf2f(bf16_t v) { return __uint_as_float(((unsigned)v) << 16); }
__device__ __forceinline__ bf16_t f2bf(float f) { unsigned u = __float_as_uint(f); return (bf16_t)((u + 0x7fffu + ((u >> 16) & 1u)) >> 16); }
__device__ __forceinline__ float rbf(float f) { return bf2f(f2bf(f)); }
__device__ __forceinline__ float sigmoidf_(float x) { return 1.f / (1.f + __expf(-x)); }
__device__ __forceinline__ float wave_sum(float v) {
#pragma unroll
    for (int o = 1; o < 64; o <<= 1) v += __shfl_xor(v, o);
    return v;
}
__device__ __forceinline__ float wave_max(float v) {
#pragma unroll
    for (int o = 1; o < 64; o <<= 1) v = fmaxf(v, __shfl_xor(v, o));
    return v;
}

__device__ __forceinline__ void sincos_turns(double turns, float& s, float& c) {
    double fr = turns - floor(turns);
    double q = floor(fr * 4.0 + 0.5);
    double r = fr - q * 0.25;
    double x = r * 6.283185307179586476925;
    double x2 = x * x;
    double sn = x * (1.0 + x2 * (-1.0 / 6 + x2 * (1.0 / 120 + x2 * (-1.0 / 5040 + x2 * (1.0 / 362880 + x2 * (-1.0 / 39916800 + x2 * (1.0 / 6227020800.0)))))));
    double cs = 1.0 + x2 * (-0.5 + x2 * (1.0 / 24 + x2 * (-1.0 / 720 + x2 * (1.0 / 40320 + x2 * (-1.0 / 3628800 + x2 * (1.0 / 479001600.0 + x2 * (-1.0 / 87178291200.0)))))));
    int qi = ((int)q) & 3;
    double so = qi == 0 ? sn : qi == 1 ? cs : qi == 2 ? -sn : -cs;
    double co = qi == 0 ? cs : qi == 1 ? -sn : qi == 2 ? -cs : sn;
    s = (float)so; c = (float)co;
}
__global__ __launch_bounds__(256) void k_prep(float* rope, float* c1, const float* pos_k, const float* pos_v, const float* w1k, const float* w1v) {
    const int gid = blockIdx.x * 256 + threadIdx.x;
    if (gid < 2048 * 16) {
        const int pos = gid >> 4, i = gid & 15;
        double f = 1.0; for (int k = 0; k < i; ++k) f *= 0.44036660267178046;
        const float inv = (float)f;
        const float ang = (float)pos * inv;
        float s, c; sincos_turns((double)ang * 0.15915494309189533577, s, c);
        rope[gid] = c; rope[2048 * 16 + gid] = s;
    }
    if (gid < 2 * 32 * 128) {
        const int j = gid & 127, kc = (gid >> 7) & 31, which = gid >> 12;
        const float* pos = which ? pos_v : pos_k; const float* w = which ? w1v : w1k;
        float a = 0.f;
        for (int k = kc * 128; k < kc * 128 + 128; ++k) a += pos[k] * w[(size_t)k * 128 + j];
        atomicAdd(c1 + which * 128 + j, a);
    }
}

__device__ __forceinline__ void adaln_unit(int unit, const float* c, const float* w_ada, const float* b_ada, float* mod, float* red  , float* sil  ) {
    const int tid = threadIdx.x, lane = tid & 63, wave = tid >> 6;
    const int cc = unit % 96, kc = unit / 96;
    { const int k = kc * 512 + tid; f32x4 s4;
#pragma unroll
      for (int b = 0; b < 4; ++b) { const float cv = c[b * DM + k]; s4[b] = cv * __builtin_amdgcn_rcpf(1.f + __expf(-cv)); }
      *(f32x4*)(sil + 4 * tid) = s4; }
    __syncthreads();
    const int col0 = cc * 256 + lane * 4;
    float acc[4][4];
#pragma unroll
    for (int b = 0; b < 4; ++b)
#pragma unroll
        for (int j = 0; j < 4; ++j) acc[b][j] = 0.f;
    const int k0 = kc * 512 + wave * 64;
#pragma unroll 16
    for (int r = 0; r < 64; ++r) {
        const int k = k0 + r;
        const f32x4 w = *(const f32x4*)(w_ada + (size_t)k * 24576 + col0);
        const f32x4 s4 = *(const f32x4*)(sil + 4 * (wave * 64 + r));
#pragma unroll
        for (int b = 0; b < 4; ++b) { const float s = s4[b];
            acc[b][0] += s * w[0]; acc[b][1] += s * w[1]; acc[b][2] += s * w[2]; acc[b][3] += s * w[3]; }
    }
#pragma unroll
    for (int b = 0; b < 4; ++b)
#pragma unroll
        for (int j = 0; j < 4; ++j) red[(wave * 4 + b) * 256 + lane * 4 + j] = acc[b][j];
    __syncthreads();
    for (int e = tid; e < 1024; e += 512) {
        const int b = e >> 8, cl = e & 255; float s = 0.f;
#pragma unroll
        for (int w = 0; w < 8; ++w) s += red[(w * 4 + b) * 256 + cl];
        if (kc == 0) s += b_ada[cc * 256 + cl];
        atomicAdd(mod + b * 24576 + cc * 256 + cl, s);
    }
    __syncthreads();
}
__global__ __launch_bounds__(512) void k_adaln(const float* c, const float* w_ada, const float* b_ada, float* mod) {
    __shared__ float red[8 * 4 * 256]; __shared__ float sil[512 * 4];
    for (int u = blockIdx.x; u < 96 * 8; u += gridDim.x) adaln_unit(u, c, w_ada, b_ada, mod, red, sil);
}

__device__ __forceinline__ void norm_mod_row(const float* xrow, const float* g, const float* scale, const float* shift, bf16_t* orow, int lane) {
    f32x4 v[16]; float ss = 0.f;
#pragma unroll
    for (int j = 0; j < 16; ++j) { v[j] = *(const f32x4*)(xrow + 256 * j + 4 * lane); ss += (v[j][0] * v[j][0] + v[j][1] * v[j][1]) + (v[j][2] * v[j][2] + v[j][3] * v[j][3]); }
    ss = wave_sum(ss);
    const float rstd = 1.0f / sqrtf(ss * (1.f / DM) + RMS_EPS);
#pragma unroll
    for (int jb = 0; jb < 16; jb += 4) {
        f32x4 gg[4], sc[4], sh[4];
#pragma unroll
        for (int jj = 0; jj < 4; ++jj) { const int col = 256 * (jb + jj) + 4 * lane; gg[jj] = *(const f32x4*)(g + col); sc[jj] = *(const f32x4*)(scale + col); sh[jj] = *(const f32x4*)(shift + col); }
#pragma unroll
        for (int jj = 0; jj < 4; ++jj) { const int j = jb + jj; const int col = 256 * j + 4 * lane;
            float o[4];
#pragma unroll
            for (int e = 0; e < 4; ++e) o[e] = (v[j][e] * rstd * gg[jj][e]) * (1.f + sc[jj][e]) + sh[jj][e];
            u32x2 w; asm("v_cvt_pk_bf16_f32 %0, %1, %2" : "=v"(w.x) : "v"(o[0]), "v"(o[1])); asm("v_cvt_pk_bf16_f32 %0, %1, %2" : "=v"(w.y) : "v"(o[2]), "v"(o[3]));
            *(u32x2*)(orow + col) = w; }
    }
}
__global__ __launch_bounds__(256) void k_norm_mod(const float* x, const float* g, const float* mod, int shift_idx, int scale_idx, bf16_t* H) {
    const int lane = threadIdx.x & 63, gw = (blockIdx.x * 256 + threadIdx.x) >> 6, nw = (gridDim.x * 256) >> 6;
    for (int row = gw; row < M; row += nw) {
        const int b = row / SEQ;
        norm_mod_row(x + (size_t)row * DM, g, mod + b * 24576 + scale_idx * DM, mod + b * 24576 + shift_idx * DM, H + (size_t)row * DM, lane);
    }
}

struct MapIdent { __device__ __forceinline__ int operator()(int n) const { return n; } };
struct MapInProj {
    __device__ __forceinline__ int operator()(int n) const {
        if (n < 5120) return n;
        if (n < 11264) return n - 5120 + 5168;
        if (n < 19456) return n - 11264 + 11328;
        if (n < 19504) return n - 19456 + 5120;
        return n - 19504 + 11312;
    }
};
struct EpiProj { bf16_t* proj; float* small;
    __device__ __forceinline__ void operator()(int row, int col, float v) const {
        if (col < C_SMALL) proj[(size_t)row * PITCH + col] = f2bf(v); else small[(size_t)row * 64 + (col - C_SMALL)] = v; } };
struct EpiUpA { const bf16_t* proj; bf16_t* y;
    __device__ __forceinline__ void operator()(int row, int col, float v) const {
        const float g = sigmoidf_(bf2f(proj[(size_t)row * PITCH + C_GA + col])); y[(size_t)row * DM + col] = f2bf(g * v); } };
struct EpiUpB { const bf16_t* proj; bf16_t* y;
    __device__ __forceinline__ void operator()(int row, int col, float v) const {
        const float g = sigmoidf_(bf2f(proj[(size_t)row * PITCH + C_GB + col])); y[(size_t)row * DM + col] = f2bf(bf2f(y[(size_t)row * DM + col]) + g * v); } };
struct EpiOut { const float* x; const float* mod; float* x1;
    __device__ __forceinline__ void operator()(int row, int col, float v) const {
        const int b = row / SEQ; x1[(size_t)row * DM + col] = x[(size_t)row * DM + col] + mod[b * 24576 + 2 * DM + col] * v; } };
struct EpiFF1 { bf16_t* a;
    __device__ __forceinline__ void operator()(int row, int col, float v) const { const float r = fmaxf(v, 0.f); a[(size_t)row * DFF + col] = f2bf(r * r); } };
struct EpiFF2 { const float* mod; float* out;
    __device__ __forceinline__ void operator()(int row, int col, float v) const {
        const int b = row / SEQ; out[(size_t)row * DM + col] = out[(size_t)row * DM + col] + mod[b * 24576 + 5 * DM + col] * v; } };

template <class Epi> struct GemmNaiveArgs { const bf16_t* A; const float* W; int ldw, N, K, pad; Epi epi; };
template <class BMap, class Epi>
__global__ __launch_bounds__(256) void k_gemm_naive(GemmNaiveArgs<Epi> ga) {
    const bf16_t* A = ga.A; const float* W = ga.W; const int ldw = ga.ldw, N = ga.N, K = ga.K; const BMap bmap; const Epi& epi = ga.epi;
    __shared__ float As[16][132];
    __shared__ float Bs[16][132];
    const int tid = threadIdx.x, tx = tid & 15, ty = tid >> 4;
    const int m0 = blockIdx.y * 128, n0 = blockIdx.x * 128;
    float acc[8][8];
#pragma unroll
    for (int i = 0; i < 8; ++i)
#pragma unroll
        for (int j = 0; j < 8; ++j) acc[i][j] = 0.f;
    const int arow = tid >> 1, akof = (tid & 1) * 8;
    const int bk = tid >> 4, bn = (tid & 15) * 4;
    for (int k0 = 0; k0 < K; k0 += 16) {
        { const u32x4 raw = *(const u32x4*)(A + (size_t)(m0 + arow) * K + k0 + akof);
#pragma unroll
          for (int e = 0; e < 4; ++e) { As[akof + 2 * e][arow] = __uint_as_float(raw[e] << 16); As[akof + 2 * e + 1][arow] = __uint_as_float(raw[e] & 0xffff0000u); } }
#pragma unroll
        for (int hh = 0; hh < 2; ++hh) { const int cn = n0 + bn + 64 * hh; f32x4 w = {0.f, 0.f, 0.f, 0.f};
            if (cn < N) w = *(const f32x4*)(W + (size_t)(k0 + bk) * ldw + bmap(cn));
            Bs[bk][bn + 64 * hh + 0] = rbf(w[0]); Bs[bk][bn + 64 * hh + 1] = rbf(w[1]); Bs[bk][bn + 64 * hh + 2] = rbf(w[2]); Bs[bk][bn + 64 * hh + 3] = rbf(w[3]); }
        __syncthreads();
#pragma unroll
        for (int kk = 0; kk < 16; ++kk) {
            float a[8], b[8];
#pragma unroll
            for (int i = 0; i < 4; ++i) { a[i] = As[kk][ty * 4 + i]; a[4 + i] = As[kk][64 + ty * 4 + i]; b[i] = Bs[kk][tx * 4 + i]; b[4 + i] = Bs[kk][64 + tx * 4 + i]; }
#pragma unroll
            for (int i = 0; i < 8; ++i)
#pragma unroll
                for (int j = 0; j < 8; ++j) acc[i][j] += a[i] * b[j];
        }
        __syncthreads();
    }
#pragma unroll
    for (int i = 0; i < 8; ++i) { const int row = m0 + (i < 4 ? ty * 4 + i : 64 + ty * 4 + i - 4);
#pragma unroll
        for (int j = 0; j < 8; ++j) { const int col = n0 + (j < 4 ? tx * 4 + j : 64 + tx * 4 + j - 4); if (col < N) epi(row, col, acc[i][j]); } }
}

__device__ __forceinline__ void post_slot(bf16_t* proj, int row, int slot, const float* nq, const float* nk, const float* fq, const float* fk, const float* rope, int lane) {
    int col; const float* g; bool do_rope;
    if (slot < 16) { col = C_NSAQ + slot * 128; g = nq; do_rope = true; }
    else if (slot < 20) { col = C_KS + (slot - 16) * 128; g = nk; do_rope = true; }
    else if (slot < 24) { col = C_KW + (slot - 20) * 128; g = nk; do_rope = true; }
    else if (slot < 40) { col = C_FQ + (slot - 24) * 128; g = fq; do_rope = false; }
    else { col = C_FK + (slot - 40) * 128; g = fk; do_rope = false; }
    unsigned* p = (unsigned*)(proj + (size_t)row * PITCH + col) + lane;
    const unsigned raw = *p;
    float x0 = __uint_as_float(raw << 16), x1 = __uint_as_float(raw & 0xffff0000u);
    const float ss = wave_sum(x0 * x0 + x1 * x1);
    const float rstd = 1.0f / sqrtf(ss * (1.f / 128.f) + RMS_EPS);
    x0 = x0 * rstd * g[2 * lane]; x1 = x1 * rstd * g[2 * lane + 1];
    if (do_rope) {
        const int t = row % SEQ;
        const float y0 = __shfl_xor(x0, 8), y1 = __shfl_xor(x1, 8);
        if (lane < 16) {
            const int i0 = (2 * lane) & 15;
            const float c0 = rope[t * 16 + i0], c1 = rope[t * 16 + i0 + 1], s0 = rope[2048 * 16 + t * 16 + i0], s1 = rope[2048 * 16 + t * 16 + i0 + 1];
            if (lane < 8) { x0 = x0 * c0 - y0 * s0; x1 = x1 * c1 - y1 * s1; }
            else          { x0 = y0 * s0 + x0 * c0; x1 = y1 * s1 + x1 * c1; }
        }
    }
    *p = (unsigned)f2bf(x0) | ((unsigned)f2bf(x1) << 16);
}
__global__ __launch_bounds__(256) void k_post(bf16_t* proj, const float* nq, const float* nk, const float* fq, const float* fk, const float* rope) {
    const int lane = threadIdx.x & 63; const long gw = ((long)blockIdx.x * 256 + threadIdx.x) >> 6, nw = ((long)gridDim.x * 256) >> 6;
    for (long it = gw; it < (long)M * 56; it += nw) post_slot(proj, (int)(it / 56), (int)(it % 56), nq, nk, fq, fk, rope, lane);
}

__device__ __forceinline__ void cumsum_bh(int bh, const float* small, const float* b_forget, float* cum, int lane) {
    const int b = bh >> 4, h = bh & 15; const float bf = b_forget[h];
    float ls[32]; double tot = 0.0;
#pragma unroll
    for (int i = 0; i < 32; ++i) ls[i] = small[((size_t)b * SEQ + lane * 32 + i) * 64 + 48 + h];
    __builtin_amdgcn_sched_barrier(0);
#pragma unroll
    for (int i = 0; i < 32; ++i) { const float x = ls[i] + bf;
        ls[i] = fminf(x, 0.f) - log1pf(expf(-fabsf(x))); tot += (double)ls[i]; }
    double inc = tot;
#pragma unroll
    for (int o = 1; o < 64; o <<= 1) { const double up = __shfl_up(inc, o); if (lane >= o) inc += up; }
    double run = inc - tot;
#pragma unroll
    for (int i = 0; i < 32; ++i) { run += (double)ls[i]; cum[(size_t)bh * SEQ + lane * 32 + i] = (float)run; }
}
__global__ __launch_bounds__(64) void k_cumsum(const float* small, const float* b_forget, float* cum) { cumsum_bh(blockIdx.x, small, b_forget, cum, threadIdx.x); }

__device__ __forceinline__ float gelu_tanh(float x) { const float u = 0.7978845608028654f * (x + 0.044715f * x * x * x); return 0.5f * x * (1.f + tanhf(u)); }
__global__ __launch_bounds__(128) void k_compress(const bf16_t* proj, const float* c1, const float* w1k, const float* w1v, const float* w2k, const float* w2v,
                                                  const float* nk, const float* rope, bf16_t* kcmp, bf16_t* vcmp) {
    __shared__ float xs[4096]; __shared__ float h1[128]; __shared__ float red[2];
    const int j = threadIdx.x; int idx = blockIdx.x;
    const int n = idx & 127; idx >>= 7; const int g = idx & 3; idx >>= 2; const int b = idx & 3; const int which = idx >> 2;
    bf16_t* out = (which ? vcmp : kcmp) + ((size_t)(b * 4 + g) * 128 + n) * 128;
    if (n >= NCMP) { out[j] = 0; return; }
    const int col = (which ? C_VC : C_KC) + g * 128;
    for (int e = j; e < 4096; e += 128) { const int l = e >> 7, d = e & 127; xs[e] = bf2f(proj[((size_t)b * SEQ + 16 * n + l) * PITCH + col + d]); }
    __syncthreads();
    const float* w1 = which ? w1v : w1k; const float* w2 = which ? w2v : w2k;
    float a = c1[which * 128 + j];
#pragma unroll 8
    for (int k = 0; k < 4096; ++k) a += xs[k] * w1[(size_t)k * 128 + j];
    h1[j] = gelu_tanh(a);
    __syncthreads();
    float o = 0.f;
#pragma unroll 8
    for (int i = 0; i < 128; ++i) o += h1[i] * w2[i * 128 + j];
    if (which == 0) {
        float ss = wave_sum(o * o);
        __syncthreads();
        if ((j & 63) == 0) red[j >> 6] = ss;
        __syncthreads();
        ss = red[0] + red[1];
        const float rstd = 1.0f / sqrtf(ss * (1.f / 128.f) + RMS_EPS);
        o = o * rstd * nk[j];
        __syncthreads();
        h1[j] = o;
        __syncthreads();
        if (j < 32) { const int t = 16 * n + 31, i = j & 15; const float c = rope[t * 16 + i], s = rope[2048 * 16 + t * 16 + i];
            const float xa = h1[i], xb = h1[i + 16]; o = (j < 16) ? xa * c - xb * s : xa * s + xb * c; }
    }
    out[j] = f2bf(o);
}


__device__ __forceinline__ void dot_row4(const bf16_t* kr, const float (*q)[128], float& a0, float& a1, float& a2, float& a3) {
#pragma unroll 4
    for (int c = 0; c < 16; ++c) { const u32x4 raw = *(const u32x4*)(kr + c * 8);
#pragma unroll
        for (int e = 0; e < 4; ++e) { const float lo = __uint_as_float(raw[e] << 16), hi = __uint_as_float(raw[e] & 0xffff0000u); const int d = c * 8 + 2 * e;
            a0 += q[0][d] * lo + q[0][d + 1] * hi; a1 += q[1][d] * lo + q[1][d + 1] * hi; a2 += q[2][d] * lo + q[2][d + 1] * hi; a3 += q[3][d] * lo + q[3][d + 1] * hi; } }
}
__device__ __forceinline__ float dot_row1(const bf16_t* kr, const float* q) {
    float a = 0.f;
#pragma unroll 4
    for (int c = 0; c < 16; ++c) { const u32x4 raw = *(const u32x4*)(kr + c * 8);
#pragma unroll
        for (int e = 0; e < 4; ++e) { const float lo = __uint_as_float(raw[e] << 16), hi = __uint_as_float(raw[e] & 0xffff0000u); const int d = c * 8 + 2 * e; a += q[d] * lo + q[d + 1] * hi; } }
    return a;
}

__global__ __launch_bounds__(64) void k_nsa_naive(const bf16_t* proj, const float* small, const bf16_t* kcmp, const bf16_t* vcmp, bf16_t* onsa) {
    __shared__ float qf[4][128]; __shared__ float sc[4][1024]; __shared__ float psum[128]; __shared__ float impS[32]; __shared__ int blk[16];
    const int lane = threadIdx.x; int idx = blockIdx.x;
    const int g = idx & 3; const int t = (idx >> 2) & (SEQ - 1); const int b = idx >> 13;
    const size_t row = (size_t)b * SEQ + t; const float NINF = -__builtin_inff();
    for (int i = lane; i < 512; i += 64) { const int r = i >> 7, d = i & 127; qf[r][d] = bf2f(proj[row * PITCH + C_NSAQ + (g * 4 + r) * 128 + d]); }
    if (lane < 16) blk[lane] = 0;
    __syncthreads();
    float oc[4][2], os[4][2], ow[4][2];
    const bf16_t* kc = kcmp + (size_t)(b * 4 + g) * 128 * 128; const bf16_t* vc = vcmp + (size_t)(b * 4 + g) * 128 * 128;
    {
        float s[4][2];
        for (int h2 = 0; h2 < 2; ++h2) { const int n = lane + 64 * h2; const bool valid = (n < NCMP) && (16 * n + 31 <= t);
            float a0 = 0.f, a1 = 0.f, a2 = 0.f, a3 = 0.f;
            if (valid) dot_row4(kc + n * 128, qf, a0, a1, a2, a3);
            s[0][h2] = valid ? a0 * ATT_SCALE : NINF; s[1][h2] = valid ? a1 * ATT_SCALE : NINF; s[2][h2] = valid ? a2 * ATT_SCALE : NINF; s[3][h2] = valid ? a3 * ATT_SCALE : NINF; }
        float ps0 = 0.f, ps1 = 0.f;
        for (int r = 0; r < 4; ++r) { float m = wave_max(fmaxf(s[r][0], s[r][1])); if (m == NINF) m = 0.f;
            float p0 = __expf(s[r][0] - m), p1 = __expf(s[r][1] - m); float sum = wave_sum(p0 + p1); const float den = sum > 0.f ? sum : 1.f;
            p0 /= den; p1 /= den; sc[r][lane] = p0; sc[r][lane + 64] = p1; ps0 += p0; ps1 += p1; }
        psum[lane] = ps0; psum[lane + 64] = ps1;
    }
    __syncthreads();
    for (int r = 0; r < 4; ++r) for (int dd = 0; dd < 2; ++dd) { const int d = lane + 64 * dd; float a = 0.f;
        for (int n = 0; n < NCMP; ++n) { const float p = sc[r][n]; if (p != 0.f) a += p * bf2f(vc[n * 128 + d]); } oc[r][dd] = a; }
    const int cur = t >> 6;
    if (lane < 32) { const int j = lane; float im = 0.f;
        for (int i = 4 * j - 1; i <= 4 * j + 3; ++i) if (i >= 0 && i < NCMP) im += psum[i];
        const bool forced = (j == 0) || (j == cur) || (j == cur - 1); const bool causal = j <= cur;
        impS[j] = forced ? __builtin_inff() : (causal ? im : NINF); }
    __syncthreads();
    bool selj = false;
    if (lane < 32) { const float sj = impS[lane]; int rank = 0;
        for (int k = 0; k < 32; ++k) { const float sk = impS[k]; if (sk > sj || (sk == sj && k < lane)) ++rank; }
        selj = (rank < 16) && (sj > NINF); }
    const unsigned selmask = (unsigned)__ballot(selj);
    __syncthreads();
    {
        int nsel = 0;
        for (int j = 0; j < 32; ++j) if ((selmask >> j) & 1u) { const int key = 64 * j + lane; const bool valid = key <= t;
            float a0 = 0.f, a1 = 0.f, a2 = 0.f, a3 = 0.f;
            if (valid) { const bf16_t* kr = proj + ((size_t)b * SEQ + key) * PITCH + C_KS + g * 128;
                dot_row4(kr, qf, a0, a1, a2, a3); }
            sc[0][nsel * 64 + lane] = valid ? a0 * ATT_SCALE : NINF; sc[1][nsel * 64 + lane] = valid ? a1 * ATT_SCALE : NINF;
            sc[2][nsel * 64 + lane] = valid ? a2 * ATT_SCALE : NINF; sc[3][nsel * 64 + lane] = valid ? a3 * ATT_SCALE : NINF;
            if (lane == 0) blk[nsel] = j; ++nsel; }
        __syncthreads();
        for (int r = 0; r < 4; ++r) { float m = NINF; for (int i = lane; i < nsel * 64; i += 64) m = fmaxf(m, sc[r][i]); m = wave_max(m); if (m == NINF) m = 0.f;
            float sum = 0.f; for (int i = lane; i < nsel * 64; i += 64) { const float p = __expf(sc[r][i] - m); sc[r][i] = p; sum += p; } sum = wave_sum(sum);
            const float den = sum > 0.f ? sum : 1.f; for (int i = lane; i < nsel * 64; i += 64) sc[r][i] /= den; }
        __syncthreads();
        for (int r = 0; r < 4; ++r) for (int dd = 0; dd < 2; ++dd) os[r][dd] = 0.f;
        for (int si = 0; si < nsel; ++si) { const int j = blk[si];
            for (int kk = 0; kk < 64; ++kk) { const int key = 64 * j + kk; if (key > t) break;
                const bf16_t* vr = proj + ((size_t)b * SEQ + key) * PITCH + C_VS + g * 128; const float v0 = bf2f(vr[lane]), v1 = bf2f(vr[lane + 64]);
                for (int r = 0; r < 4; ++r) { const float p = sc[r][si * 64 + kk]; os[r][0] += p * v0; os[r][1] += p * v1; } } }
    }
    __syncthreads();
    {
        const int klo = t - 511 > 0 ? t - 511 : 0; const int nk = t - klo + 1;
        for (int i = lane; i < 512; i += 64) { const bool valid = i < nk; float a0 = 0.f, a1 = 0.f, a2 = 0.f, a3 = 0.f;
            if (valid) { const bf16_t* kr = proj + ((size_t)b * SEQ + klo + i) * PITCH + C_KW + g * 128;
                dot_row4(kr, qf, a0, a1, a2, a3); }
            sc[0][i] = valid ? a0 * ATT_SCALE : NINF; sc[1][i] = valid ? a1 * ATT_SCALE : NINF; sc[2][i] = valid ? a2 * ATT_SCALE : NINF; sc[3][i] = valid ? a3 * ATT_SCALE : NINF; }
        __syncthreads();
        for (int r = 0; r < 4; ++r) { float m = NINF; for (int i = lane; i < 512; i += 64) m = fmaxf(m, sc[r][i]); m = wave_max(m); if (m == NINF) m = 0.f;
            float sum = 0.f; for (int i = lane; i < 512; i += 64) { const float p = __expf(sc[r][i] - m); sc[r][i] = p; sum += p; } sum = wave_sum(sum);
            const float den = sum > 0.f ? sum : 1.f; for (int i = lane; i < 512; i += 64) sc[r][i] /= den; }
        __syncthreads();
        for (int r = 0; r < 4; ++r) for (int dd = 0; dd < 2; ++dd) ow[r][dd] = 0.f;
        for (int i = 0; i < nk; ++i) { const bf16_t* vr = proj + ((size_t)b * SEQ + klo + i) * PITCH + C_VW + g * 128; const float v0 = bf2f(vr[lane]), v1 = bf2f(vr[lane + 64]);
            for (int r = 0; r < 4; ++r) { const float p = sc[r][i]; ow[r][0] += p * v0; ow[r][1] += p * v1; } }
    }
    for (int r = 0; r < 4; ++r) { const int head = g * 4 + r; const float* gl = small + row * 64 + head * 3;
        const float g0 = sigmoidf_(gl[0]), g1 = sigmoidf_(gl[1]), g2 = sigmoidf_(gl[2]);
        for (int dd = 0; dd < 2; ++dd) onsa[row * 2048 + head * 128 + lane + 64 * dd] = f2bf(g0 * oc[r][dd] + g1 * os[r][dd] + g2 * ow[r][dd]); }
}

__global__ __launch_bounds__(64) void k_fox_naive(const bf16_t* proj, const float* cum, bf16_t* ofox) {
    __shared__ float qf[128]; __shared__ float sc[2048];
    const int lane = threadIdx.x; int idx = blockIdx.x;
    const int h = idx & 15; const int t = (idx >> 4) & (SEQ - 1); const int b = idx >> 15;
    const size_t row = (size_t)b * SEQ + t;
    qf[lane] = bf2f(proj[row * PITCH + C_FQ + h * 128 + lane]); qf[lane + 64] = bf2f(proj[row * PITCH + C_FQ + h * 128 + lane + 64]);
    __syncthreads();
    const float* cm = cum + (size_t)(b * 16 + h) * SEQ; const float ct = cm[t];
    float m = -__builtin_inff();
    for (int s = lane; s <= t; s += 64) { const bf16_t* kr = proj + ((size_t)b * SEQ + s) * PITCH + C_FK + h * 128; float a = dot_row1(kr, qf);
        a = a * ATT_SCALE + (ct - cm[s]); sc[s] = a; m = fmaxf(m, a); }
    m = wave_max(m);
    float sum = 0.f;
    for (int s = lane; s <= t; s += 64) { const float p = __expf(sc[s] - m); sc[s] = p; sum += p; }
    sum = wave_sum(sum);
    __syncthreads();
    float o0 = 0.f, o1 = 0.f;
    for (int s = 0; s <= t; ++s) { const bf16_t* vr = proj + ((size_t)b * SEQ + s) * PITCH + C_FV + h * 128; const float p = sc[s]; o0 += p * bf2f(vr[lane]); o1 += p * bf2f(vr[lane + 64]); }
    ofox[row * 2048 + h * 128 + lane] = f2bf(o0 / sum); ofox[row * 2048 + h * 128 + lane + 64] = f2bf(o1 / sum);
}


namespace pg8 {
#define PG8_LAS __attribute__((address_space(3)))
typedef unsigned short bf16_t;
typedef short bf16x8 __attribute__((ext_vector_type(8)));
typedef float f32x4 __attribute__((ext_vector_type(4)));
typedef unsigned u32x4 __attribute__((ext_vector_type(4)));
constexpr int BM = 256, BK = 64, HALF = 128, HTB = HALF * BK * 2  , STAGE_BYTES = 8 * HTB, NXCD = 8, WGM = 8;

__host__ __device__ __forceinline__ int lds_byte(int r, int c) { const int st = (r >> 4) * 2 + (c >> 5), rr = r & 15, cc = c & 31, ob = rr * 64 + cc * 2; return st * 1024 + (ob ^ (((ob >> 9) & 1) << 5)); }
__host__ __device__ __forceinline__ void stage_rc(int b, int& R, int& C) { const int st = b / 1024, sb = b % 1024, swz = sb ^ (((sb >> 9) & 1) << 5); R = (st >> 1) * 16 + swz / 64; C = (st & 1) * 32 + (swz % 64) / 2; }
__host__ __device__ __forceinline__ int perm32(int rho) { const int n = rho >> 4, i = rho & 15; return 8 * (i >> 2) + 4 * n + (i & 3); }

struct Unit { int pm, pn; };
struct Gemm { const bf16_t* A; const bf16_t* Bt; int M, N, K; };

struct StaticOrder {
    int nM, nN, nwg, G, c;
    __host__ __device__ void init(int M, int N, int G_, int c_) { nM = M / BM; nN = N / BM; nwg = nM * nN; G = G_; c = c_; }
    __host__ __device__ bool next(int i, Unit& u) const {
        const long L = (long)i * G + c; if (L >= nwg) return false;
        int wgid = (int)L; { const int q = nwg / NXCD, r = nwg % NXCD, xcd = wgid % NXCD, off = wgid / NXCD; wgid = (xcd < r ? xcd * (q + 1) : r * (q + 1) + (xcd - r) * q) + off; }
        const int nig = WGM * nN, gid = wgid / nig, fm = gid * WGM, gsz = (nM - fm) < WGM ? (nM - fm) : WGM;
        u.pm = fm + ((wgid % nig) % gsz); u.pn = (wgid % nig) / gsz; return true;
    }
    __device__ __forceinline__ void a_ready(const Unit&) const {}
    __device__ __forceinline__ void done(const Unit&) const {}
};

__device__ __forceinline__ unsigned cvt_pk_bf16(float lo, float hi) { unsigned r; asm("v_cvt_pk_bf16_f32 %0, %1, %2" : "=v"(r) : "v"(lo), "v"(hi)); return r; }
typedef float f32x2 __attribute__((ext_vector_type(2)));

template <class Epi, class Sched, bool ALIGN_EPI = false, bool SP2 = false>
__device__ __forceinline__ void gemm_phase(PG8_LAS unsigned char* lds, const Gemm g, const Sched& S, const Epi& E, const int tid) {
    const int wid = __builtin_amdgcn_readfirstlane(tid >> 6), lane = tid & 63, wr = wid >> 2, wc = wid & 3, fr = lane & 15, fq = lane >> 4;
    const int K = g.K, nt = K / BK;
    unsigned voffA[2], voffB[2];
#pragma unroll
    for (int i = 0; i < 2; ++i) { int R, C; stage_rc(tid * 16 + i * 8192, R, C); const int Rb = Epi::PERM ? ((R & ~31) + perm32(R & 31)) : R;
        voffA[i] = (unsigned)(R * K + C) * 2u; voffB[i] = (unsigned)(Rb * K + C) * 2u; }
    const size_t kstep = (size_t)(BK * 2);
    const size_t hstep = (size_t)HALF * K * 2;
    const size_t tstep = 2 * hstep;
    const unsigned ldsw = (unsigned)wid * 1024u;
    const int aoff = lds_byte(wr * 64 + fr, fq * 8), boff = lds_byte(wc * 32 + fr, fq * 8);
#define PG8_SA(b, h) (((b) * 2 + (h)) * HTB)
#define PG8_SB(b, h) ((4 + (b) * 2 + (h)) * HTB)
#define PG8_STAGE(bufoff, gbase, voff) do { _Pragma("unroll") for (int _i = 0; _i < 2; ++_i) \
        __builtin_amdgcn_global_load_lds((const unsigned*)((const char*)(gbase) + (voff)[_i]), (PG8_LAS unsigned*)(lds + (bufoff) + ldsw + _i * 8192), 16, 0, 0); } while (0)
#define PG8_LDA(dst, b, h) do { _Pragma("unroll") for (int m = 0; m < 4; ++m) _Pragma("unroll") for (int k = 0; k < 2; ++k) dst[m][k] = *(const PG8_LAS bf16x8*)(lds + PG8_SA(b, h) + aoff + m * 2048 + k * 1024); } while (0)
#define PG8_LDB(dst, b, h) do { _Pragma("unroll") for (int n = 0; n < 2; ++n) _Pragma("unroll") for (int k = 0; k < 2; ++k) dst[n][k] = *(const PG8_LAS bf16x8*)(lds + PG8_SB(b, h) + boff + n * 2048 + k * 1024); } while (0)
#define PG8_MMA(ai, bj, At, Bt) do { __builtin_amdgcn_s_setprio(1); _Pragma("unroll") for (int m = 0; m < 4; ++m) _Pragma("unroll") for (int n = 0; n < 2; ++n) _Pragma("unroll") for (int k = 0; k < 2; ++k) \
        acc[ai][bj][m][n] = __builtin_amdgcn_mfma_f32_16x16x32_bf16(Bt[n][k], At[m][k], acc[ai][bj][m][n], 0, 0, 0); __builtin_amdgcn_s_setprio(0); } while (0)
#define PG8_WAIT_V(n) asm volatile("s_waitcnt vmcnt(" #n ")" ::: "memory")
#define PG8_WAIT_L(n) asm volatile("s_waitcnt lgkmcnt(" #n ")" ::: "memory")
#define PG8_BAR __builtin_amdgcn_s_barrier()
#define PG8_SCHED __builtin_amdgcn_sched_barrier(0)
    Unit cur, nxt; int ui = 0;
    if (!S.next(0, cur)) return;
    f32x4 acc[2][2][4][2];
#pragma unroll
    for (int a = 0; a < 2; ++a)
#pragma unroll
        for (int b = 0; b < 2; ++b)
#pragma unroll
            for (int m = 0; m < 4; ++m)
#pragma unroll
                for (int n = 0; n < 2; ++n) acc[a][b][m][n] = (f32x4){0.f, 0.f, 0.f, 0.f};
    bf16x8 At[4][2], B0[2][2], B1[2][2];
    const char* cA = (const char*)g.A + (size_t)cur.pm * tstep; const char* cB = (const char*)g.Bt + (size_t)cur.pn * tstep;
    S.a_ready(cur);
    if constexpr (SP2) {
        PG8_STAGE(PG8_SB(0, 0), cB, voffB); PG8_STAGE(PG8_SB(0, 1), cB + hstep, voffB); PG8_STAGE(PG8_SA(0, 0), cA, voffA); PG8_STAGE(PG8_SA(0, 1), cA + hstep, voffA);
        if (wr == 1) PG8_BAR;
        PG8_WAIT_V(2); PG8_BAR;
        PG8_STAGE(PG8_SB(1, 0), cB + kstep, voffB); PG8_STAGE(PG8_SA(1, 0), cA + kstep, voffA); PG8_STAGE(PG8_SB(1, 1), cB + hstep + kstep, voffB);
        PG8_WAIT_V(6); PG8_BAR;
    } else {
        PG8_STAGE(PG8_SB(0, 0), cB, voffB); PG8_STAGE(PG8_SA(0, 0), cA, voffA); PG8_STAGE(PG8_SB(0, 1), cB + hstep, voffB); PG8_STAGE(PG8_SA(0, 1), cA + hstep, voffA);
        if (wr == 1) PG8_BAR;
        PG8_WAIT_V(4); PG8_BAR;
        PG8_STAGE(PG8_SB(1, 0), cB + kstep, voffB); PG8_STAGE(PG8_SA(1, 0), cA + kstep, voffA); PG8_STAGE(PG8_SB(1, 1), cB + hstep + kstep, voffB);
        PG8_WAIT_V(6); PG8_BAR;
    }
    for (;;) {
        const bool has_next = S.next(ui + 1, nxt);
        const char* nA = has_next ? (const char*)g.A + (size_t)nxt.pm * tstep : cA; const char* nB = has_next ? (const char*)g.Bt + (size_t)nxt.pn * tstep : cB;
        for (int t = 0; t < nt; t += 2) {
            const bool last = (t == nt - 2);
            const char* a1 = cA + (size_t)(t + 1) * kstep;
            const char* a2 = last ? nA : cA + (size_t)(t + 2) * kstep; const char* b2 = last ? nB : cB + (size_t)(t + 2) * kstep;
            const char* a3 = a2 + kstep; const char* b3 = b2 + kstep;
            if (last && has_next) S.a_ready(nxt);
            if constexpr (Epi::HAS_PRE) { if (last) E.pre(cur, wr, wc, fr, fq); }
            if constexpr (SP2) {
            PG8_LDB(B0, 0, 0); PG8_LDB(B1, 0, 1); PG8_SCHED; PG8_LDA(At, 0, 0); PG8_STAGE(PG8_SA(1, 1), a1 + hstep, voffA);
            PG8_WAIT_V(8); PG8_WAIT_L(0); PG8_BAR; PG8_MMA(0, 0, At, B0); PG8_MMA(0, 1, At, B1); PG8_BAR; PG8_SCHED;
            PG8_LDA(At, 0, 1); PG8_STAGE(PG8_SB(0, 0), b2, voffB); PG8_STAGE(PG8_SB(0, 1), b2 + hstep, voffB); PG8_STAGE(PG8_SA(0, 0), a2, voffA);
            PG8_WAIT_V(8); PG8_WAIT_L(0); PG8_BAR; PG8_MMA(1, 0, At, B0); PG8_MMA(1, 1, At, B1); PG8_BAR; PG8_SCHED;
            PG8_LDB(B0, 1, 0); PG8_LDB(B1, 1, 1); PG8_SCHED; PG8_LDA(At, 1, 0); PG8_STAGE(PG8_SA(0, 1), a2 + hstep, voffA);
            PG8_WAIT_V(8); PG8_WAIT_L(0); PG8_BAR; PG8_MMA(0, 0, At, B0); PG8_MMA(0, 1, At, B1); PG8_BAR; PG8_SCHED;
            PG8_LDA(At, 1, 1); PG8_STAGE(PG8_SB(1, 0), b3, voffB); PG8_STAGE(PG8_SB(1, 1), b3 + hstep, voffB); PG8_STAGE(PG8_SA(1, 0), a3, voffA);
            PG8_WAIT_V(8); PG8_WAIT_L(0); PG8_BAR; PG8_MMA(1, 0, At, B0); PG8_MMA(1, 1, At, B1); PG8_BAR; PG8_SCHED;
            } else {
            PG8_LDB(B0, 0, 0); PG8_SCHED; PG8_LDA(At, 0, 0); PG8_STAGE(PG8_SA(1, 1), a1 + hstep, voffA);
            PG8_WAIT_L(8); PG8_BAR; PG8_WAIT_L(0); PG8_MMA(0, 0, At, B0); PG8_BAR; PG8_SCHED;
            PG8_LDB(B1, 0, 1); PG8_STAGE(PG8_SB(0, 0), b2, voffB);
            PG8_BAR; PG8_WAIT_L(0); PG8_MMA(0, 1, At, B1); PG8_BAR;
            PG8_LDA(At, 0, 1); PG8_STAGE(PG8_SA(0, 0), a2, voffA);
            PG8_BAR; PG8_WAIT_L(0); PG8_MMA(1, 0, At, B0); PG8_BAR; PG8_SCHED;
            PG8_STAGE(PG8_SB(0, 1), b2 + hstep, voffB);
            PG8_WAIT_V(6); PG8_BAR; PG8_MMA(1, 1, At, B1); PG8_BAR;
            PG8_LDB(B0, 1, 0); PG8_SCHED; PG8_LDA(At, 1, 0); PG8_STAGE(PG8_SA(0, 1), a2 + hstep, voffA);
            PG8_WAIT_L(8); PG8_BAR; PG8_WAIT_L(0); PG8_MMA(0, 0, At, B0); PG8_BAR; PG8_SCHED;
            PG8_LDB(B1, 1, 1); PG8_STAGE(PG8_SB(1, 0), b3, voffB);
            PG8_BAR; PG8_WAIT_L(0); PG8_MMA(0, 1, At, B1); PG8_BAR;
            PG8_LDA(At, 1, 1); PG8_STAGE(PG8_SA(1, 0), a3, voffA);
            PG8_BAR; PG8_WAIT_L(0); PG8_MMA(1, 0, At, B0); PG8_BAR; PG8_SCHED;
            PG8_STAGE(PG8_SB(1, 1), b3 + hstep, voffB);
            PG8_WAIT_V(6); PG8_BAR; PG8_MMA(1, 1, At, B1); PG8_BAR;
            }
        }
        if constexpr (ALIGN_EPI) { if (wr == 0) PG8_BAR; }
        if constexpr (!Epi::AFTER_DRAIN) { E(acc, cur, wr, wc, fr, fq); S.done(cur); }
        if (!has_next) break;
#pragma unroll
        for (int a = 0; a < 2; ++a)
#pragma unroll
            for (int b = 0; b < 2; ++b)
#pragma unroll
                for (int m = 0; m < 4; ++m)
#pragma unroll
                    for (int n = 0; n < 2; ++n) acc[a][b][m][n] = (f32x4){0.f, 0.f, 0.f, 0.f};
        cur = nxt; cA = nA; cB = nB; ++ui;
        if constexpr (ALIGN_EPI) { if (wr == 1) PG8_BAR; }
    }
    PG8_WAIT_V(0);
    if constexpr (!ALIGN_EPI) { if (wr == 0) PG8_BAR; }
    PG8_BAR;
    if constexpr (Epi::AFTER_DRAIN) { E.fused(acc, cur, wr, wc, fr, fq, lds, wid, lane); S.done(cur); }
#undef PG8_SA
#undef PG8_SB
#undef PG8_STAGE
#undef PG8_LDA
#undef PG8_LDB
#undef PG8_MMA
#undef PG8_WAIT_V
#undef PG8_WAIT_L
#undef PG8_BAR
#undef PG8_SCHED
}
}


namespace pg8 {
__device__ __forceinline__ float sigm(float x) { return __builtin_amdgcn_rcpf(1.f + __expf(-x));     }
__device__ __forceinline__ void unpack8(const u32x4 w, float (&f)[8]) {
#pragma unroll
    for (int e = 0; e < 4; ++e) { f[2 * e] = __uint_as_float(w[e] << 16); f[2 * e + 1] = __uint_as_float(w[e] & 0xffff0000u); }
}
struct EpiProjF { static constexpr bool PERM = true, AFTER_DRAIN = false, HAS_PRE = false; bf16_t* proj; float* small;
    __device__ __forceinline__ void operator()(const f32x4 (&acc)[2][2][4][2], const Unit& u, int wr, int wc, int fr, int fq) const {
        const int row0 = u.pm * BM + wr * 64 + fr;
        if (u.pn < 76) {
            const int col0 = u.pn * BM + wc * 32 + 8 * fq;
#pragma unroll
            for (int ai = 0; ai < 2; ++ai)
#pragma unroll
                for (int m = 0; m < 4; ++m) { bf16_t* rowp = proj + (size_t)(row0 + ai * HALF + m * 16) * PITCH + col0;
#pragma unroll
                    for (int bj = 0; bj < 2; ++bj) { const f32x4 v0 = acc[ai][bj][m][0], v1 = acc[ai][bj][m][1];
                        u32x4 w; w.x = cvt_pk_bf16(v0[0], v0[1]); w.y = cvt_pk_bf16(v0[2], v0[3]); w.z = cvt_pk_bf16(v1[0], v1[1]); w.w = cvt_pk_bf16(v1[2], v1[3]);
                        *(u32x4*)(rowp + bj * HALF) = w; } }
        } else if (wc < 2) {
#pragma unroll
            for (int ai = 0; ai < 2; ++ai)
#pragma unroll
                for (int m = 0; m < 4; ++m) { float* rp = small + (size_t)(row0 + ai * HALF + m * 16) * 64 + wc * 32 + 8 * fq;
                    *(f32x4*)rp = acc[ai][0][m][0]; *(f32x4*)(rp + 4) = acc[ai][0][m][1]; }
        }
    }
};
template <bool UPB> struct EpiUpF { static constexpr bool PERM = true, AFTER_DRAIN = false, HAS_PRE = false; const bf16_t* proj; bf16_t* y;
    __device__ __forceinline__ void operator()(const f32x4 (&acc)[2][2][4][2], const Unit& u, int wr, int wc, int fr, int fq) const {
        const int row0 = u.pm * BM + wr * 64 + fr; const int col0 = u.pn * BM + wc * 32 + 8 * fq;
#pragma unroll
        for (int ai = 0; ai < 2; ++ai)
#pragma unroll
            for (int m = 0; m < 4; ++m) { const size_t row = (size_t)(row0 + ai * HALF + m * 16);
#pragma unroll
                for (int bj = 0; bj < 2; ++bj) { const int col = col0 + bj * HALF;
                    const u32x4 gw = *(const u32x4*)(proj + row * PITCH + (UPB ? C_GB : C_GA) + col); float g[8]; unpack8(gw, g);
                    const f32x4 v0 = acc[ai][bj][m][0], v1 = acc[ai][bj][m][1];
                    float o[8] = {v0[0], v0[1], v0[2], v0[3], v1[0], v1[1], v1[2], v1[3]};
#pragma unroll
                    for (int e = 0; e < 8; ++e) o[e] *= sigm(g[e]);
                    if (UPB) { const u32x4 yw = *(const u32x4*)(y + row * DM + col); float yo[8]; unpack8(yw, yo);
#pragma unroll
                        for (int e = 0; e < 8; ++e) o[e] += yo[e]; }
                    u32x4 w; w.x = cvt_pk_bf16(o[0], o[1]); w.y = cvt_pk_bf16(o[2], o[3]); w.z = cvt_pk_bf16(o[4], o[5]); w.w = cvt_pk_bf16(o[6], o[7]);
                    *(u32x4*)(y + row * DM + col) = w; } }
    }
};
struct UpOrder { StaticOrder base;
    __device__ __forceinline__ bool next(int i, Unit& u) const { Unit t; if (!base.next(i >> 1, t)) return false; u.pm = t.pm + (i & 1) * (M / BM); u.pn = t.pn + (i & 1) * (DM / BM); return true; }
    __device__ __forceinline__ void a_ready(const Unit&) const {}
    __device__ __forceinline__ void done(const Unit&) const {}
};
struct EpiUpCat { static constexpr bool PERM = true, AFTER_DRAIN = false, HAS_PRE = false; const bf16_t* proj; bf16_t* y;
    __device__ __forceinline__ void operator()(const f32x4 (&acc)[2][2][4][2], const Unit& u, int wr, int wc, int fr, int fq) const {
        const bool upb = u.pm >= M / BM; const int pm = upb ? u.pm - M / BM : u.pm, pn = upb ? u.pn - DM / BM : u.pn;
        const int row0 = pm * BM + wr * 64 + fr; const int col0 = pn * BM + wc * 32 + 8 * fq; const int gcol = upb ? C_GB : C_GA;
#pragma unroll
        for (int ai = 0; ai < 2; ++ai) {
            u32x4 gw[4][2], yw[4][2];
#pragma unroll
            for (int m = 0; m < 4; ++m)
#pragma unroll
                for (int bj = 0; bj < 2; ++bj) gw[m][bj] = *(const u32x4*)(proj + (size_t)(row0 + ai * HALF + m * 16) * PITCH + gcol + col0 + bj * HALF);
            if (upb) {
#pragma unroll
                for (int m = 0; m < 4; ++m)
#pragma unroll
                    for (int bj = 0; bj < 2; ++bj) yw[m][bj] = *(const u32x4*)(y + (size_t)(row0 + ai * HALF + m * 16) * DM + col0 + bj * HALF);
            }
#pragma unroll
            for (int m = 0; m < 4; ++m) { const size_t row = (size_t)(row0 + ai * HALF + m * 16);
#pragma unroll
                for (int bj = 0; bj < 2; ++bj) { const int col = col0 + bj * HALF;
                    float g[8]; unpack8(gw[m][bj], g);
                    const f32x4 v0 = acc[ai][bj][m][0], v1 = acc[ai][bj][m][1];
                    float o[8] = {v0[0], v0[1], v0[2], v0[3], v1[0], v1[1], v1[2], v1[3]};
#pragma unroll
                    for (int e = 0; e < 8; ++e) o[e] *= sigm(g[e]);
                    if (upb) { float yo[8]; unpack8(yw[m][bj], yo);
#pragma unroll
                        for (int e = 0; e < 8; ++e) o[e] += yo[e]; }
                    u32x4 w; w.x = cvt_pk_bf16(o[0], o[1]); w.y = cvt_pk_bf16(o[2], o[3]); w.z = cvt_pk_bf16(o[4], o[5]); w.w = cvt_pk_bf16(o[6], o[7]);
                    *(u32x4*)(y + row * DM + col) = w; } }
        }
    }
};
struct EpiResF { static constexpr bool PERM = false, AFTER_DRAIN = false, HAS_PRE = false; const float* base; const float* gate  ; float* out;
    __device__ __forceinline__ void operator()(const f32x4 (&acc)[2][2][4][2], const Unit& u, int wr, int wc, int fr, int fq) const {
        const int row0 = u.pm * BM + wr * 64 + fr; const int col0 = u.pn * BM + wc * 32 + 4 * fq;
        const float* gb = gate + (size_t)((u.pm * BM) / SEQ) * 24576;
        f32x4 gv[2][2];
#pragma unroll
        for (int bj = 0; bj < 2; ++bj)
#pragma unroll
            for (int n = 0; n < 2; ++n) gv[bj][n] = *(const f32x4*)(gb + col0 + bj * HALF + n * 16);
#pragma unroll
        for (int ai = 0; ai < 2; ++ai) {
            f32x4 bs[4][2][2];
#pragma unroll
            for (int m = 0; m < 4; ++m)
#pragma unroll
                for (int bj = 0; bj < 2; ++bj)
#pragma unroll
                    for (int n = 0; n < 2; ++n) bs[m][bj][n] = *(const f32x4*)(base + (size_t)(row0 + ai * HALF + m * 16) * DM + col0 + bj * HALF + n * 16);
#pragma unroll
            for (int m = 0; m < 4; ++m) { const size_t off = (size_t)(row0 + ai * HALF + m * 16) * DM + col0;
#pragma unroll
                for (int bj = 0; bj < 2; ++bj)
#pragma unroll
                    for (int n = 0; n < 2; ++n) *(f32x4*)(out + off + bj * HALF + n * 16) = bs[m][bj][n] + gv[bj][n] * acc[ai][bj][m][n]; }
        }
    }
};
struct EpiResNormF { static constexpr bool PERM = true, AFTER_DRAIN = false, HAS_PRE = false; const float* base; const float* gate; float* out; const float* g2; const float* scale2  ; bf16_t* an; float* ss;
    __device__ __forceinline__ void operator()(const f32x4 (&acc)[2][2][4][2], const Unit& u, int wr, int wc, int fr, int fq) const {
        const int row0 = u.pm * BM + wr * 64 + fr; const int col0 = u.pn * BM + wc * 32 + 8 * fq;
        const size_t boff = (size_t)((u.pm * BM) / SEQ) * 24576;
        f32x4 gv[2][2], gs[2][2];
#pragma unroll
        for (int bj = 0; bj < 2; ++bj)
#pragma unroll
            for (int n = 0; n < 2; ++n) { const int c = col0 + bj * HALF + n * 4; gv[bj][n] = *(const f32x4*)(gate + boff + c);
                const f32x4 g = *(const f32x4*)(g2 + c), sc = *(const f32x4*)(scale2 + boff + c); gs[bj][n] = g + g * sc; }
#pragma unroll
        for (int ai = 0; ai < 2; ++ai)
#pragma unroll
          for (int mh = 0; mh < 4; mh += 2) {
            f32x4 bsv[2][2][2];
#pragma unroll
            for (int mm = 0; mm < 2; ++mm)
#pragma unroll
                for (int bj = 0; bj < 2; ++bj)
#pragma unroll
                    for (int n = 0; n < 2; ++n) bsv[mm][bj][n] = *(const f32x4*)(base + (size_t)(row0 + ai * HALF + (mh + mm) * 16) * DM + col0 + bj * HALF + n * 4);
#pragma unroll
            for (int mm = 0; mm < 2; ++mm) { const int m = mh + mm; const int row = row0 + ai * HALF + m * 16; const size_t off = (size_t)row * DM + col0; float rs = 0.f;
#pragma unroll
                for (int bj = 0; bj < 2; ++bj) { u32x4 w;
#pragma unroll
                    for (int n = 0; n < 2; ++n) { const f32x4 bs = bsv[mm][bj][n];
                        const f32x4 o = bs + gv[bj][n] * acc[ai][bj][m][n];
                        *(f32x4*)(out + off + bj * HALF + n * 4) = o;
                        rs += (o[0] * o[0] + o[1] * o[1]) + (o[2] * o[2] + o[3] * o[3]);
                        const f32x4 a = o * gs[bj][n];
                        if (n == 0) { w.x = cvt_pk_bf16(a[0], a[1]); w.y = cvt_pk_bf16(a[2], a[3]); } else { w.z = cvt_pk_bf16(a[0], a[1]); w.w = cvt_pk_bf16(a[2], a[3]); } }
                    *(u32x4*)(an + off + bj * HALF) = w; }
                rs += __shfl_xor(rs, 16); rs += __shfl_xor(rs, 32);
                if (fq == 0) atomicAdd(ss + row, rs); }
          }
    }
};
struct EpiFF1NF { static constexpr bool PERM = true, AFTER_DRAIN = false, HAS_PRE = true; bf16_t* a; const float* ss; const float* cb  ;
    mutable float pss[2][4]; mutable f32x4 pcv[2][2];
    __device__ __forceinline__ void pre(const Unit& u, int wr, int wc, int fr, int fq) const {
        const int row0 = u.pm * BM + wr * 64 + fr; const int col0 = u.pn * BM + wc * 32 + 8 * fq;
        const float* cbb = cb + (size_t)((u.pm * BM) / SEQ) * DFF + col0;
        const float* sp = ss + row0;
#define PRE_LD1(dst, off) asm volatile("global_load_dword %0, %1, off offset:" #off : "=v"(dst) : "v"(sp) : "memory")
        PRE_LD1(pss[0][0], 0); PRE_LD1(pss[0][1], 64); PRE_LD1(pss[0][2], 128); PRE_LD1(pss[0][3], 192);
        PRE_LD1(pss[1][0], 512); PRE_LD1(pss[1][1], 576); PRE_LD1(pss[1][2], 640); PRE_LD1(pss[1][3], 704);
#undef PRE_LD1
#define PRE_LD4(dst, off) asm volatile("global_load_dwordx4 %0, %1, off offset:" #off : "=v"(dst) : "v"(cbb) : "memory")
        PRE_LD4(pcv[0][0], 0); PRE_LD4(pcv[0][1], 16); PRE_LD4(pcv[1][0], 512); PRE_LD4(pcv[1][1], 528);
#undef PRE_LD4
    }
    __device__ __forceinline__ void operator()(const f32x4 (&acc)[2][2][4][2], const Unit& u, int wr, int wc, int fr, int fq) const {
        const int row0 = u.pm * BM + wr * 64 + fr; const int col0 = u.pn * BM + wc * 32 + 8 * fq;
#pragma unroll
        for (int ai = 0; ai < 2; ++ai)
#pragma unroll
            for (int m = 0; m < 4; ++m) { bf16_t* rowp = a + (size_t)(row0 + ai * HALF + m * 16) * DFF + col0;
                const float rd = __builtin_amdgcn_rsqf(pss[ai][m] * (1.f / DM) + RMS_EPS);
#pragma unroll
                for (int bj = 0; bj < 2; ++bj) { f32x4 v0 = acc[ai][bj][m][0] * rd + pcv[bj][0], v1 = acc[ai][bj][m][1] * rd + pcv[bj][1];
                    f32x4 r0, r1;
#pragma unroll
                    for (int e = 0; e < 4; ++e) { asm("v_max_f32 %0, 0, %1" : "=v"(r0[e]) : "v"(v0[e])); asm("v_max_f32 %0, 0, %1" : "=v"(r1[e]) : "v"(v1[e])); }
                    v0 = v0 * r0; v1 = v1 * r1;
                    u32x4 w; w.x = cvt_pk_bf16(v0[0], v0[1]); w.y = cvt_pk_bf16(v0[2], v0[3]); w.z = cvt_pk_bf16(v1[0], v1[1]); w.w = cvt_pk_bf16(v1[2], v1[3]);
                    *(u32x4*)(rowp + bj * HALF) = w; } }
    }
};
struct EpiFF1F { static constexpr bool PERM = true, AFTER_DRAIN = false, HAS_PRE = false; bf16_t* a;
    __device__ __forceinline__ void operator()(const f32x4 (&acc)[2][2][4][2], const Unit& u, int wr, int wc, int fr, int fq) const {
        const int row0 = u.pm * BM + wr * 64 + fr; const int col0 = u.pn * BM + wc * 32 + 8 * fq;
#pragma unroll
        for (int ai = 0; ai < 2; ++ai)
#pragma unroll
            for (int m = 0; m < 4; ++m) { bf16_t* rowp = a + (size_t)(row0 + ai * HALF + m * 16) * DFF + col0;
#pragma unroll
                for (int bj = 0; bj < 2; ++bj) { f32x4 v0 = acc[ai][bj][m][0], v1 = acc[ai][bj][m][1];
                    f32x4 r0, r1;
#pragma unroll
                    for (int e = 0; e < 4; ++e) { asm("v_max_f32 %0, 0, %1" : "=v"(r0[e]) : "v"(v0[e])); asm("v_max_f32 %0, 0, %1" : "=v"(r1[e]) : "v"(v1[e])); }
                    v0 = v0 * r0; v1 = v1 * r1;
                    u32x4 w; w.x = cvt_pk_bf16(v0[0], v0[1]); w.y = cvt_pk_bf16(v0[2], v0[3]); w.z = cvt_pk_bf16(v1[0], v1[1]); w.w = cvt_pk_bf16(v1[2], v1[3]);
                    *(u32x4*)(rowp + bj * HALF) = w; } }
    }
};
}

constexpr int NWAVES = 8;
constexpr int NPHASE = 10;
constexpr size_t WS_WIN_T = 512 * MiB, WS_WUPA_T = 672 * MiB, WS_WUPB_T = 688 * MiB, WS_WOUT_T = 704 * MiB, WS_WFF1_T = 736 * MiB, WS_WFF2_T = 864 * MiB;
static_assert(WS_PROJ + (size_t)M * PITCH * 2 <= WS_WIN_T && WS_WIN_T + (size_t)PITCH * DM * 2 <= WS_WUPA_T && WS_WFF2_T + (size_t)DM * DFF * 2 <= WS_END, "ws map");
constexpr int CW_QUEUE = 64;
constexpr int CW_BAR = 4096;
constexpr int LDS_GEN = 0;
constexpr int MISC_OFF = 151 * 1024;
constexpr int LDS_BYTES = 152 * 1024;

#define LAS __attribute__((address_space(3)))
#define GAS __attribute__((address_space(1)))
typedef GAS unsigned gu32;
#define RLX_AGENT __ATOMIC_RELAXED, __HIP_MEMORY_SCOPE_AGENT
#define XB_TMO      128
#define XB_XCNT(j)  (256  + 64 * (j))
#define XB_XSUB(j)  (1280 + 64 * (j))
#define XB_XGEN(j)  (2304 + 64 * (j))
#define XB_TOP      3328
#define XB_TOPGEN   3392
#define XCD_BAR_WORDS 3456
#define XB_SPIN_CAP (1u << 18)

__device__ __forceinline__ unsigned xb_ld(unsigned* p)              { return __hip_atomic_load(p, __ATOMIC_RELAXED, __HIP_MEMORY_SCOPE_AGENT); }
__device__ __forceinline__ unsigned xb_add(unsigned* p, unsigned v) { return __hip_atomic_fetch_add(p, v, __ATOMIC_RELAXED, __HIP_MEMORY_SCOPE_AGENT); }
__device__ __forceinline__ unsigned xb_xcc_id() { return (unsigned)__builtin_amdgcn_s_getreg((3 << 11) | 20) & 0xFu; }
#define XB_SPIN(cond, bar) do { unsigned _sp = 0; while (cond) { __builtin_amdgcn_s_sleep(1); \
    if ((++_sp & 255u) == 0u) { if (xb_ld(&(bar)[XB_TMO])) break; if (_sp > XB_SPIN_CAP) { atomicAdd(&(bar)[XB_TMO], 1u); break; } } } } while (0)

struct XcdBarrier {
    unsigned* bar; unsigned x;
    volatile LAS unsigned* st;
};

__device__ __forceinline__ XcdBarrier xcd_barrier_post(unsigned* bar, volatile LAS unsigned* st, const int tid) {
    XcdBarrier b; b.bar = bar; b.x = xb_xcc_id(); b.st = st;
    if (tid == 0) (void)xb_add(&bar[XB_XCNT(b.x)], 1u);
    return b;
}
__device__ __forceinline__ void xcd_barrier_complete(unsigned* bar, unsigned x, unsigned& nloc, unsigned& nx) {
    const unsigned G = gridDim.x * gridDim.y * gridDim.z;
    unsigned sum, cnt, mine, sp = 0u;
    for (;;) {
        sum = 0u; cnt = 0u; mine = 0u;
#pragma unroll
        for (unsigned j = 0; j < 16; ++j) { const unsigned c = xb_ld(&bar[XB_XCNT(j)]); sum += c; cnt += (c > 0u) ? 1u : 0u; mine = (j == x) ? c : mine; }
        if (sum == G) break;
        __builtin_amdgcn_s_sleep(1);
        if ((++sp & 255u) == 0u) { if (xb_ld(&bar[XB_TMO])) break; if (sp > XB_SPIN_CAP) { atomicAdd(&bar[XB_TMO], 1u); break; } }
    }
    nloc = mine > 0u ? mine : 1u; nx = cnt > 0u ? cnt : 1u;
}

__device__ __forceinline__ void xcd_barrier(const XcdBarrier& b, const int tid) {
    asm volatile("s_waitcnt vmcnt(0)" ::: "memory");
    __syncthreads();
    if (tid == 0) {
        unsigned* bar = b.bar;
        __builtin_amdgcn_s_waitcnt(0);
        unsigned nloc = b.st[0], nx = b.st[1];
        if (nloc == 0u) { xcd_barrier_complete(bar, b.x, nloc, nx); b.st[0] = nloc; b.st[1] = nx; }
        const unsigned old = xb_add(&bar[XB_XSUB(b.x)], 1u);
        const unsigned gen = old / nloc;
        if (old + 1u == (gen + 1u) * nloc) {
            __builtin_amdgcn_fence(__ATOMIC_RELEASE, "agent");
            asm volatile("s_waitcnt vmcnt(0)" ::: "memory");
            const unsigned og = xb_add(&bar[XB_TOP], 1u);
            const unsigned tg = og / nx;
            if (og + 1u == (tg + 1u) * nx) xb_add(&bar[XB_TOPGEN], 1u);
            else XB_SPIN(xb_ld(&bar[XB_TOPGEN]) == tg, bar);
            __builtin_amdgcn_fence(__ATOMIC_ACQUIRE, "agent");
            xb_add(&bar[XB_XGEN(b.x)], 1u);
            asm volatile("s_waitcnt vmcnt(0)" ::: "memory");
        } else {
            XB_SPIN(xb_ld(&bar[XB_XGEN(b.x)]) == gen, bar);
            __builtin_amdgcn_fence(__ATOMIC_ACQUIRE, "agent");
            asm volatile("s_waitcnt vmcnt(0)" ::: "memory");
        }
    }
    __syncthreads();
}

static_assert(CW_BAR + 3 * XCD_BAR_WORDS <= (int)(WS_MOD / 4), "barrier words inside the zeroed CTL region, below MOD");

__device__ __forceinline__ unsigned cvt_pk_nv(float lo, float hi) { unsigned r; asm("v_cvt_pk_bf16_f32 %0, %1, %2" : "=v"(r) : "v"(lo), "v"(hi)); return r; }
struct TrDesc { const float* W; bf16_t* WT; int ldw, oldc0, K, new_r0, kb, ncols; float* cacc; };
__device__ __forceinline__ void tr_load(const TrDesc& d, f32x4 (&v)[16], int lane) {
    const int k0 = 64 * d.kb, l15 = lane & 15, lq = lane >> 4;
#pragma unroll
    for (int i = 0; i < 16; ++i) v[i] = *(const f32x4*)(d.W + (size_t)(k0 + 8 * (i >> 1) + 2 * lq + (i & 1)) * d.ldw + d.oldc0 + 4 * l15);
}
__device__ __forceinline__ void tr_finish(const TrDesc& d, const f32x4 (&v)[16], LAS float* scr_f, int lane) {
    LAS unsigned* scr = (LAS unsigned*)scr_f;
    const int k0 = 64 * d.kb, l15 = lane & 15, lq = lane >> 4;
    const int sw = (l15 & 7) << 2;
#pragma unroll
    for (int i = 0; i < 8; ++i) { const int kp = (4 * i + lq) ^ sw;
#pragma unroll
        for (int e = 0; e < 4; ++e) scr[(4 * l15 + e) * 32 + kp] = cvt_pk_nv(v[2 * i][e], v[2 * i + 1][e]); }
    asm volatile("s_waitcnt lgkmcnt(0)" ::: "memory");
    const int c = lane & 7;
    u32x4 o[8];
#pragma unroll
    for (int j = 0; j < 8; ++j) { const int n = (lane >> 3) + 8 * j; o[j] = *(const LAS u32x4*)(scr + n * 32 + 4 * (c ^ ((n >> 2) & 7))); }
#pragma unroll
    for (int j = 0; j < 8; ++j) { const int n = (lane >> 3) + 8 * j;
        if (n < d.ncols) *(u32x4*)(d.WT + (size_t)(d.new_r0 + n) * d.K + k0 + 8 * c) = o[j]; }
    asm volatile("s_waitcnt lgkmcnt(0)" ::: "memory");
}
__device__ __forceinline__ void tr_shiftdot(const TrDesc& d, const f32x4 (&v)[16], int lane, const LAS float* shl) {
    const int l15 = lane & 15, lq = lane >> 4;
    float a[4][4];
#pragma unroll
    for (int b = 0; b < 4; ++b)
#pragma unroll
        for (int e = 0; e < 4; ++e) a[b][e] = 0.f;
#pragma unroll
    for (int i = 0; i < 8; ++i)
#pragma unroll
        for (int b = 0; b < 4; ++b) { const pg8::f32x2 s = *(const LAS pg8::f32x2*)(shl + b * 64 + 8 * i + 2 * lq);
#pragma unroll
            for (int e = 0; e < 4; ++e) a[b][e] += s[0] * v[2 * i][e] + s[1] * v[2 * i + 1][e]; }
    const bool hi0 = lq & 1, hi1 = lq >> 1;
    float* dst = d.cacc + d.new_r0 + 4 * l15 + 2 * (lq & 1) + (lq >> 1);
#pragma unroll
    for (int b = 0; b < 4; ++b) {
        const float k0 = hi0 ? a[b][2] : a[b][0], k1 = hi0 ? a[b][3] : a[b][1];
        const float g0 = hi0 ? a[b][0] : a[b][2], g1 = hi0 ? a[b][1] : a[b][3];
        const float p0 = k0 + __shfl_xor(g0, 16), p1 = k1 + __shfl_xor(g1, 16);
        const float kk = hi1 ? p1 : p0, gg = hi1 ? p0 : p1;
        atomicAdd(dst + b * DFF, kk + __shfl_xor(gg, 32)); }
}
template <class Dec>
__device__ __forceinline__ void tr_run(const Dec& dec, int it0, int stride, int end, LAS float* scr, int lane, const LAS float* shl = nullptr) {
    if (it0 >= end) return;
    TrDesc da = dec(it0), db = da; f32x4 va[16], vb[16]; tr_load(da, va, lane);
    for (int it = it0;;) {
        int itn = it + stride; bool more = itn < end;
        db = dec(more ? itn : it); tr_load(db, vb, lane);
        tr_finish(da, va, scr, lane); if (shl && da.cacc) tr_shiftdot(da, va, lane, shl);
        if (!more) break;
        it = itn; itn = it + stride; more = itn < end;
        da = dec(more ? itn : it); tr_load(da, va, lane);
        tr_finish(db, vb, scr, lane); if (shl && db.cacc) tr_shiftdot(db, vb, lane, shl);
        if (!more) break;
        it = itn;
    }
}
constexpr int TI_IN = 306 * 64, TI_UP = 64 * 32, TI_OUT = 64 * 64, TI_FF1 = 256 * 64, TI_FF2 = 64 * 256;
constexpr int TI_C1 = 2 * 64, TI_C2 = 2 * 2;
constexpr int TI_A = TI_IN + 2 * TI_C1 + 2 * TI_C2;
constexpr int TI_B = 2 * TI_UP + TI_OUT + TI_FF1 + TI_FF2, TI_FF1_0 = 2 * TI_UP + TI_OUT + TI_FF2;
constexpr int CONV_KT = 13;
struct ConvB { const float *w_up_nsa, *w_up_fox, *w_out, *w_ff1, *w_ff2; bf16_t *WUPA_T, *WUPB_T, *WOUT_T, *WFF1_T, *WFF2_T; float* cbv; };
struct DecB { ConvB cb;
    __device__ __forceinline__ TrDesc operator()(int r) const {
        if (r < TI_UP) return TrDesc{cb.w_up_nsa, cb.WUPA_T, DM, (r % 64) * 64, 2048, (r % 64) * 64, r / 64, 64}; r -= TI_UP;
        if (r < TI_UP) return TrDesc{cb.w_up_fox, cb.WUPB_T, DM, (r % 64) * 64, 2048, (r % 64) * 64, r / 64, 64}; r -= TI_UP;
        if (r < TI_OUT) return TrDesc{cb.w_out, cb.WOUT_T, DM, (r % 64) * 64, DM, (r % 64) * 64, r / 64, 64}; r -= TI_OUT;
        if (r < TI_FF2) return TrDesc{cb.w_ff2, cb.WFF2_T, DM, (r % 64) * 64, DFF, (r % 64) * 64, r / 64, 64}; r -= TI_FF2;
        return TrDesc{cb.w_ff1, cb.WFF1_T, DFF, (r % 256) * 64, DM, (r % 256) * 64, r / 256, 64, cb.cbv};
    } };
struct DecA { const float *w_in, *w_cmp_k1, *w_cmp_v1, *w_cmp_k2, *w_cmp_v2; bf16_t *WIN_T, *WC1K_T, *WC1V_T, *WC2K_T, *WC2V_T;
    __device__ __forceinline__ TrDesc operator()(int r) const {
        if (r < TI_IN) { const int cb = r % 306, kb = r / 306; int oldc, newc, nc = 64;
            if (cb < 80) { oldc = cb * 64; newc = cb * 64; }
            else if (cb < 176) { oldc = 5168 + (cb - 80) * 64; newc = 5120 + (cb - 80) * 64; }
            else if (cb < 304) { oldc = 11328 + (cb - 176) * 64; newc = 11264 + (cb - 176) * 64; }
            else if (cb == 304) { oldc = 5120; newc = 19456; nc = 48; }
            else { oldc = 11312; newc = 19504; nc = 16; }
            return TrDesc{w_in, WIN_T, N_IN_OLD, oldc, DM, newc, kb, nc}; }
        r -= TI_IN;
        if (r < TI_C1) return TrDesc{w_cmp_k1, WC1K_T, 128, (r % 2) * 64, 4096, (r % 2) * 64, r / 2, 64}; r -= TI_C1;
        if (r < TI_C1) return TrDesc{w_cmp_v1, WC1V_T, 128, (r % 2) * 64, 4096, (r % 2) * 64, r / 2, 64}; r -= TI_C1;
        if (r < TI_C2) return TrDesc{w_cmp_k2, WC2K_T, 128, (r % 2) * 64, 128, (r % 2) * 64, r / 2, 64}; r -= TI_C2;
        return TrDesc{w_cmp_v2, WC2V_T, 128, (r % 2) * 64, 128, (r % 2) * 64, r / 2, 64};
    } };


__device__ __forceinline__ void post_row(bf16_t* proj, int row, const float* nq, const float* nk, const float* fqn, const float* fkn, const float* rope, int lane) {
    const int l16 = lane & 15, sg = lane >> 4, t = row % SEQ;
    bf16_t* rp = proj + (size_t)row * PITCH + 8 * l16;
    u32x4 raw[14];
#pragma unroll
    for (int p = 0; p < 14; ++p) { if (p < 4 || (p >= 6 && p < 10)) continue;
        const int slot = 4 * p + sg;
        const int col = p < 4 ? slot * 128 : p == 4 ? C_KS + (slot - 16) * 128 : p == 5 ? C_KW + (slot - 20) * 128 : p < 10 ? C_FQ + (slot - 24) * 128 : C_FK + (slot - 40) * 128;
        raw[p] = *(const u32x4*)(rp + col); }
#pragma unroll
    for (int p = 0; p < 14; ++p) { if (p < 4 || (p >= 6 && p < 10)) continue;
        const int slot = 4 * p + sg;
        const int col = p < 4 ? slot * 128 : p == 4 ? C_KS + (slot - 16) * 128 : p == 5 ? C_KW + (slot - 20) * 128 : p < 10 ? C_FQ + (slot - 24) * 128 : C_FK + (slot - 40) * 128;
        const float* g = p < 4 ? nq : p < 6 ? nk : p < 10 ? fqn : fkn;
        float v[8]; pg8::unpack8(raw[p], v);
        float ss = 0.f;
#pragma unroll
        for (int e = 0; e < 8; ++e) ss += v[e] * v[e];
        ss += __shfl_xor(ss, 1); ss += __shfl_xor(ss, 2); ss += __shfl_xor(ss, 4); ss += __shfl_xor(ss, 8);
        const float rstd = 1.0f / sqrtf(ss * (1.f / 128.f) + RMS_EPS);
        const f32x4 g0 = *(const f32x4*)(g + 8 * l16), g1 = *(const f32x4*)(g + 8 * l16 + 4);
#pragma unroll
        for (int e = 0; e < 4; ++e) { v[e] = v[e] * rstd * g0[e]; v[4 + e] = v[4 + e] * rstd * g1[e]; }
        if (p < 6) {
            float y[8];
#pragma unroll
            for (int e = 0; e < 8; ++e) y[e] = __shfl_xor(v[e], 2);
            if (l16 < 4) {
                const int i0 = (8 * l16) & 15;
                const f32x4 ca = *(const f32x4*)(rope + t * 16 + i0), cb = *(const f32x4*)(rope + t * 16 + i0 + 4);
                const f32x4 sa = *(const f32x4*)(rope + 2048 * 16 + t * 16 + i0), sb = *(const f32x4*)(rope + 2048 * 16 + t * 16 + i0 + 4);
#pragma unroll
                for (int e = 0; e < 8; ++e) { const float cc = e < 4 ? ca[e] : cb[e - 4], sn = e < 4 ? sa[e] : sb[e - 4];
                    v[e] = (l16 < 2) ? v[e] * cc - y[e] * sn : y[e] * sn + v[e] * cc; }
            }
        }
        u32x4 w; w.x = pg8::cvt_pk_bf16(v[0], v[1]); w.y = pg8::cvt_pk_bf16(v[2], v[3]); w.z = pg8::cvt_pk_bf16(v[4], v[5]); w.w = pg8::cvt_pk_bf16(v[6], v[7]);
        *(u32x4*)(rp + col) = w; }
}
typedef short bf16x8_t __attribute__((ext_vector_type(8)));
__device__ __forceinline__ float gelu_fast(float x) { const float u = 0.7978845608028654f * (x + 0.044715f * x * x * x); const float e = __expf(2.f * u); return 0.5f * x * (2.f - 2.f * __builtin_amdgcn_rcpf(e + 1.f)); }
__device__ __forceinline__ void compress_s1(int id, const bf16_t* proj, const bf16_t* w1k_t, const bf16_t* w1v_t, float* PB, int lane) {
    const int cu = id >> 6, mt = (id >> 3) & 7, ng = id & 7;
    const int which = cu >> 4, b = (cu >> 2) & 3, g = cu & 3;
    const int fr = lane & 15, fq = lane >> 4;
    const int lh = ng >> 2, j0 = ((2 * ng) & 7) * 16;
    const bf16_t* abase = proj + ((size_t)b * SEQ + 16 * (16 * mt + fr)) * PITCH + (which ? C_VC : C_KC) + g * 128 + 8 * fq;
    const bf16_t* bbase = (which ? w1v_t : w1k_t) + (size_t)(j0 + fr) * 4096 + lh * 2048 + 8 * fq;
    f32x4 a0 = (f32x4){0.f, 0.f, 0.f, 0.f}, a1 = (f32x4){0.f, 0.f, 0.f, 0.f};
    bf16x8_t fa[2][8], fb0[2][8], fb1[2][8];
#define CS1_LOAD(st, kb) _Pragma("unroll") for (int j = 0; j < 8; ++j) { const int ks = 8 * (kb) + j; \
        fa[st][j] = *(const bf16x8_t*)(abase + (size_t)(ks >> 2) * PITCH + (ks & 3) * 32); fb0[st][j] = *(const bf16x8_t*)(bbase + ks * 32); fb1[st][j] = *(const bf16x8_t*)(bbase + (size_t)16 * 4096 + ks * 32); }
#define CS1_MMA(st) _Pragma("unroll") for (int j = 0; j < 8; ++j) { a0 = __builtin_amdgcn_mfma_f32_16x16x32_bf16(fb0[st][j], fa[st][j], a0, 0, 0, 0); a1 = __builtin_amdgcn_mfma_f32_16x16x32_bf16(fb1[st][j], fa[st][j], a1, 0, 0, 0); }
#define CS1_SB __builtin_amdgcn_sched_barrier(0)
    CS1_LOAD(0, 0); CS1_SB;
#pragma unroll
    for (int kb = 0; kb < 8; kb += 2) {
        CS1_LOAD(1, kb + 1); CS1_SB; CS1_MMA(0); CS1_SB;
        if (kb + 2 < 8) { CS1_LOAD(0, kb + 2); } CS1_SB; CS1_MMA(1); CS1_SB;
    }
#undef CS1_LOAD
#undef CS1_MMA
#undef CS1_SB
    float* pp = PB + ((size_t)(cu * 2 + lh) * 128 + 16 * mt + fr) * 128 + j0 + 4 * fq;
    *(f32x4*)pp = a0; *(f32x4*)(pp + 16) = a1;
}
__device__ __forceinline__ void compress_s2(int which, const float* P0g, const float* P1g, const bf16_t* w2t, const float* c1, const float* nk, const float* rope, bf16_t* outp, int wave, int lane) {
    const int fr = lane & 15, fq = lane >> 4;
    const int n = 16 * wave + fr, n1 = n + 1 < 128 ? n + 1 : 127;
    f32x4 o[8];
#pragma unroll
    for (int i = 0; i < 8; ++i) o[i] = (f32x4){0.f, 0.f, 0.f, 0.f};
    f32x4 pv[4][6];
#pragma unroll
    for (int ks = 0; ks < 4; ++ks) { const int i0 = 32 * ks + 8 * fq;
        pv[ks][0] = *(const f32x4*)(P0g + n * 128 + i0); pv[ks][1] = *(const f32x4*)(P0g + n * 128 + i0 + 4);
        pv[ks][2] = *(const f32x4*)(P1g + n1 * 128 + i0); pv[ks][3] = *(const f32x4*)(P1g + n1 * 128 + i0 + 4);
        pv[ks][4] = *(const f32x4*)(c1 + i0); pv[ks][5] = *(const f32x4*)(c1 + i0 + 4); }
    __builtin_amdgcn_sched_barrier(0);
#pragma unroll
    for (int kh = 0; kh < 2; ++kh) {
        bf16x8_t wf[2][8];
#pragma unroll
        for (int kk = 0; kk < 2; ++kk)
#pragma unroll
            for (int nt = 0; nt < 8; ++nt) wf[kk][nt] = *(const bf16x8_t*)(w2t + (size_t)(nt * 16 + fr) * 128 + 32 * (2 * kh + kk) + 8 * fq);
        __builtin_amdgcn_sched_barrier(0);
#pragma unroll
        for (int kk = 0; kk < 2; ++kk) { const int ks = 2 * kh + kk;
            float h[8];
#pragma unroll
            for (int e = 0; e < 4; ++e) { h[e] = gelu_fast(pv[ks][0][e] + pv[ks][2][e] + pv[ks][4][e]); h[4 + e] = gelu_fast(pv[ks][1][e] + pv[ks][3][e] + pv[ks][5][e]); }
            u32x4 hw; hw.x = pg8::cvt_pk_bf16(h[0], h[1]); hw.y = pg8::cvt_pk_bf16(h[2], h[3]); hw.z = pg8::cvt_pk_bf16(h[4], h[5]); hw.w = pg8::cvt_pk_bf16(h[6], h[7]);
            const bf16x8_t af = __builtin_bit_cast(bf16x8_t, hw);
#pragma unroll
            for (int nt = 0; nt < 8; ++nt) o[nt] = __builtin_amdgcn_mfma_f32_16x16x32_bf16(wf[kk][nt], af, o[nt], 0, 0, 0); }
        __builtin_amdgcn_sched_barrier(0);
    }
    if (which == 0) {
        float ss = 0.f;
#pragma unroll
        for (int nt = 0; nt < 8; ++nt) ss += (o[nt][0] * o[nt][0] + o[nt][1] * o[nt][1]) + (o[nt][2] * o[nt][2] + o[nt][3] * o[nt][3]);
        ss += __shfl_xor(ss, 16); ss += __shfl_xor(ss, 32);
        const float rstd = 1.0f / sqrtf(ss * (1.f / 128.f) + RMS_EPS);
#pragma unroll
        for (int nt = 0; nt < 8; ++nt) { const f32x4 gg = *(const f32x4*)(nk + nt * 16 + 4 * fq); o[nt] = o[nt] * rstd * gg; }
        int t = 16 * n + 31; t = t < SEQ ? t : SEQ - 1;
        const f32x4 cc = *(const f32x4*)(rope + t * 16 + 4 * fq), sn = *(const f32x4*)(rope + 2048 * 16 + t * 16 + 4 * fq);
        const f32x4 x1 = o[0], x2 = o[1];
        o[0] = x1 * cc - x2 * sn; o[1] = x1 * sn + x2 * cc;
    }
#pragma unroll
    for (int nt = 0; nt < 8; ++nt) { u32x2 w; w.x = pg8::cvt_pk_bf16(o[nt][0], o[nt][1]); w.y = pg8::cvt_pk_bf16(o[nt][2], o[nt][3]);
        if (n >= NCMP) { w.x = 0u; w.y = 0u; }
        *(u32x2*)(outp + (size_t)n * 128 + nt * 16 + 4 * fq) = w; }
}

namespace att {
typedef short bf16x8 __attribute__((ext_vector_type(8)));
typedef short s16x4 __attribute__((ext_vector_type(4)));
typedef float f32x16 __attribute__((ext_vector_type(16)));
constexpr float LOG2E = 1.4426950408889634f;
constexpr float C2 = LOG2E * ATT_SCALE;
constexpr float THR = 8.f;
constexpr unsigned BIGW = 0x40000000u;
constexpr int SHM = 16384;
constexpr int L_V = 0, L_K = 32768, L_WS = 65536, L_GATE = 67584  , L_KB = 70656, L_PSUM = 71680, L_IMP = 104448, L_OFIN = 71680  , L_SELM = 137216, L_UN = 137472, L_Q = 137536;
#define KSWZ(row, colB) ((row) * 256 + ((colB) ^ (((row) & 7) << 4)))
__device__ __forceinline__ int v_st(int k, int c) { const int kk = (k & ~0xC) | ((k & 4) << 1) | ((k & 8) >> 1); return ((kk >> 3) * 4 + (c >> 5)) * 512 + ((kk & 7) * 32 + (c & 31)) * 2; }
__device__ __forceinline__ int v_rd_base(int lane) { return ((lane & 3) << 3) | (((lane >> 2) & 3) << 6) | (((lane >> 4) & 1) << 5) | (((lane >> 5) & 1) << 8); }
constexpr int v_rd_off(int d0, int ks, int half) { return d0 * 512 + ks * 4096 + half * 2048; }
__device__ __forceinline__ int crow(int r, int hi) { return (r & 3) + 8 * (r >> 2) + 4 * hi; }
__device__ __forceinline__ unsigned cvtpk(float lo, float hi) { unsigned r; asm("v_cvt_pk_bf16_f32 %0, %1, %2" : "=v"(r) : "v"(lo), "v"(hi)); return r; }
__device__ __forceinline__ void mask_tile(f32x16& p0, f32x16& p1, int dq, unsigned W) {
    const float NEG = -__builtin_inff();
#pragma unroll
    for (int r = 0; r < 16; ++r) { const int c = (r & 3) + 8 * (r >> 2);
        if ((unsigned)(dq - c) >= W) p0[r] = NEG;
        if ((unsigned)(dq - c - 32) >= W) p1[r] = NEG; }
}
template <bool PRE>
__device__ __forceinline__ void partialSM(f32x16& p0, f32x16& p1, float& m_reg, float& alpha) {
    float pmax = p0[0];
#pragma unroll
    for (int r = 1; r < 16; ++r) pmax = fmaxf(pmax, p0[r]);
#pragma unroll
    for (int r = 0; r < 16; ++r) pmax = fmaxf(pmax, p1[r]);
    { auto rr = __builtin_amdgcn_permlane32_swap(__float_as_uint(pmax), __float_as_uint(pmax), false, false);
      pmax = fmaxf(__uint_as_float(rr[0]), __uint_as_float(rr[1])); }
    float mn;
    if (__builtin_expect(__all((pmax - m_reg) * (PRE ? 1.f : ATT_SCALE) <= (PRE ? THR * LOG2E : THR)), 1)) { mn = m_reg; alpha = 1.f; }
    else { mn = fmaxf(m_reg, pmax); alpha = __builtin_amdgcn_exp2f((m_reg - mn) * (PRE ? 1.f : C2)); m_reg = mn; }
    if (PRE) {
#pragma unroll
        for (int r = 0; r < 16; ++r) { p0[r] = p0[r] - mn; p1[r] = p1[r] - mn; }
    } else {
        const float mnL = -mn * C2;
#pragma unroll
        for (int r = 0; r < 16; ++r) { p0[r] = fmaf(p0[r], C2, mnL); p1[r] = fmaf(p1[r], C2, mnL); }
    }
#pragma unroll
    for (int r = 0; r < 16; ++r) p0[r] = __builtin_amdgcn_exp2f(p0[r]);
}
__device__ __forceinline__ void packP(const f32x16& p0, const f32x16& p1, bf16x8& pa0, bf16x8& pa1, bf16x8& pa2, bf16x8& pa3) {
#define PK4(P, B_, OUT) do { unsigned a0 = cvtpk(P[B_+0], P[B_+1]), a1 = cvtpk(P[B_+2], P[B_+3]);                          \
        unsigned b0 = cvtpk(P[B_+4], P[B_+5]), b1 = cvtpk(P[B_+6], P[B_+7]);                                             \
        auto r0 = __builtin_amdgcn_permlane32_swap(a0, b0, false, false); auto r1 = __builtin_amdgcn_permlane32_swap(a1, b1, false, false); \
        u32x4 w = {r0[0], r1[0], r0[1], r1[1]}; OUT = __builtin_bit_cast(bf16x8, w); } while (0)
    PK4(p0, 0, pa0); PK4(p0, 8, pa1); PK4(p1, 0, pa2); PK4(p1, 8, pa3);
#undef PK4
}
__device__ __forceinline__ void finishSM(f32x16& p0, f32x16& p1, float alpha, float& l_reg, bf16x8& pa0, bf16x8& pa1, bf16x8& pa2, bf16x8& pa3) {
#pragma unroll
    for (int r = 0; r < 16; ++r) p1[r] = __builtin_amdgcn_exp2f(p1[r]);
    float ps = 0.f;
#pragma unroll
    for (int r = 0; r < 16; ++r) ps += p0[r];
#pragma unroll
    for (int r = 0; r < 16; ++r) ps += p1[r];
    { auto rr = __builtin_amdgcn_permlane32_swap(__float_as_uint(ps), __float_as_uint(ps), false, false);
      ps = __uint_as_float(rr[0]) + __uint_as_float(rr[1]); }
    l_reg = l_reg * alpha + ps;
    packP(p0, p1, pa0, pa1, pa2, pa3);
}
__device__ __forceinline__ void qkt(f32x16& p0, f32x16& p1, const LAS unsigned char* Kb, int r32, int hi, const bf16x8 (&qr)[8]) {
    p0 = f32x16{}; p1 = f32x16{};
    const LAS unsigned char* kb[4];
#pragma unroll
    for (int dd = 0; dd < 4; ++dd) kb[dd] = Kb + KSWZ(r32, (dd * 16 + hi * 8) * 2);
#pragma unroll
    for (int d0 = 0; d0 < 8; ++d0) { const LAS unsigned char* a = kb[d0 & 3] + (d0 >> 2) * 128;
        const bf16x8 b0 = *(const LAS bf16x8*)a;
        const bf16x8 b1 = *(const LAS bf16x8*)(a + 32 * 256);
        p0 = __builtin_amdgcn_mfma_f32_32x32x16_bf16(b0, qr[d0], p0, 0, 0, 0);
        p1 = __builtin_amdgcn_mfma_f32_32x32x16_bf16(b1, qr[d0], p1, 0, 0, 0);
        if (d0 == 3) __builtin_amdgcn_sched_barrier(0); }
}
__device__ __forceinline__ void pv_tile(f32x16 (&o)[4], int vb, bf16x8 pa0, bf16x8 pa1, bf16x8 pa2, bf16x8 pa3) {
#define TRRD(dst, off) asm volatile("ds_read_b64_tr_b16 %0, %1 offset:%2" : "=&v"(dst) : "v"(vb), "i"(off) : "memory")
#define PV_RD(S, d0) do { constexpr int b_ = v_rd_off(d0, 0, 0); \
        TRRD(S##l0, b_); TRRD(S##h0, b_ + 2048); TRRD(S##l1, b_ + 4096); TRRD(S##h1, b_ + 6144); TRRD(S##l2, b_ + 8192); TRRD(S##h2, b_ + 10240); TRRD(S##l3, b_ + 12288); TRRD(S##h3, b_ + 14336); } while (0)
#define PV_MM(S, d0) do { \
        o[d0] = __builtin_amdgcn_mfma_f32_32x32x16_bf16(pa0, (bf16x8){S##l0[0], S##l0[1], S##l0[2], S##l0[3], S##h0[0], S##h0[1], S##h0[2], S##h0[3]}, o[d0], 0, 0, 0);   \
        o[d0] = __builtin_amdgcn_mfma_f32_32x32x16_bf16(pa1, (bf16x8){S##l1[0], S##l1[1], S##l1[2], S##l1[3], S##h1[0], S##h1[1], S##h1[2], S##h1[3]}, o[d0], 0, 0, 0);   \
        o[d0] = __builtin_amdgcn_mfma_f32_32x32x16_bf16(pa2, (bf16x8){S##l2[0], S##l2[1], S##l2[2], S##l2[3], S##h2[0], S##h2[1], S##h2[2], S##h2[3]}, o[d0], 0, 0, 0);   \
        o[d0] = __builtin_amdgcn_mfma_f32_32x32x16_bf16(pa3, (bf16x8){S##l3[0], S##l3[1], S##l3[2], S##l3[3], S##h3[0], S##h3[1], S##h3[2], S##h3[3]}, o[d0], 0, 0, 0); } while (0)
#define PV_WAIT(n) do { asm volatile("s_waitcnt lgkmcnt(" #n ")" ::: "memory"); __builtin_amdgcn_sched_barrier(0); } while (0)
    s16x4 al0, al1, al2, al3, ah0, ah1, ah2, ah3, bl0, bl1, bl2, bl3, bh0, bh1, bh2, bh3;
    PV_RD(a, 0); PV_RD(b, 1);
    PV_WAIT(8); PV_MM(a, 0); __builtin_amdgcn_sched_barrier(0);
    PV_RD(a, 2);
    PV_WAIT(8); PV_MM(b, 1); __builtin_amdgcn_sched_barrier(0);
    PV_RD(b, 3);
    PV_WAIT(8); PV_MM(a, 2); __builtin_amdgcn_sched_barrier(0);
    PV_WAIT(0); PV_MM(b, 3);
#undef PV_WAIT
#undef PV_MM
#undef PV_RD
#undef TRRD
}
__device__ __forceinline__ void rescale(f32x16 (&o)[4], float alpha, LAS float* al_l, int r32, int hi) {
    if (__any(alpha < 1.f)) { if (hi == 0) al_l[r32] = alpha; asm volatile("s_waitcnt lgkmcnt(0)" ::: "memory");
#pragma unroll
        for (int r = 0; r < 16; ++r) { const float a = al_l[crow(r, hi)];
#pragma unroll
            for (int d = 0; d < 4; ++d) o[d][r] *= a; } }
}
enum { M_SEL = 0, M_WIN = 1, M_FOX = 2 };
__device__ __forceinline__ float quad_sum(float v) {
    v += __builtin_bit_cast(float, __builtin_amdgcn_update_dpp(0, __builtin_bit_cast(int, v), 0xB1, 0xf, 0xf, false));
    v += __builtin_bit_cast(float, __builtin_amdgcn_update_dpp(0, __builtin_bit_cast(int, v), 0x4E, 0xf, 0xf, false));
    return v;
}
template <int MODE>
__device__ __forceinline__ void attn_stream(LAS unsigned char* lds, const bf16_t* Kg, const bf16_t* Vg, unsigned tiles, const bf16x8 (&qr)[8], f32x16 (&o)[4], float& m_reg, float& l_reg,
                                            int qpos, int qlo, int qhi, unsigned mysel, const float* cumrow, int tid, int wid, int lane) {
    const int r32 = lane & 31, hi = lane >> 5;
    const int sr = tid >> 4, sc = (tid & 15) * 8;
    const int kws = KSWZ(sr, sc * 2), vst0 = v_st(sr, sc), vst1 = v_st(32 + sr, sc);
    const int vb0 = (int)(uintptr_t)(lds + L_V) + v_rd_base(lane);
    LAS float* al_l = (LAS float*)(lds + L_WS) + wid * 64 + 32;
    LAS float* kbl = (LAS float*)(lds + L_KB);
    bf16x8 sk0, sk1, sv0, sv1; float skb = 0.f;
    const unsigned toff = (unsigned)(sr * PITCH + sc) * 2u;
#define LOADT(jj) do { const char* kt_ = (const char*)Kg + (size_t)(jj) * (64 * PITCH * 2); const char* vt_ = (const char*)Vg + (size_t)(jj) * (64 * PITCH * 2); \
        sk0 = *(const bf16x8*)(kt_ + toff); sk1 = *(const bf16x8*)(kt_ + (size_t)32 * PITCH * 2 + toff); sv0 = *(const bf16x8*)(vt_ + toff); sv1 = *(const bf16x8*)(vt_ + (size_t)32 * PITCH * 2 + toff); \
        if (MODE == M_FOX && tid < 64) skb = -cumrow[64 * (jj) + tid] * LOG2E; } while (0)
#define WRITET(bf) do { *(LAS bf16x8*)(lds + L_K + (bf) * SHM + kws) = sk0; *(LAS bf16x8*)(lds + L_K + (bf) * SHM + kws + 32 * 256) = sk1; \
        *(LAS bf16x8*)(lds + L_V + (bf) * SHM + vst0) = sv0; *(LAS bf16x8*)(lds + L_V + (bf) * SHM + vst1) = sv1; \
        if (MODE == M_FOX && tid < 64) kbl[(bf) * 64 + tid] = skb; } while (0)
    int j = __builtin_ctz(tiles); tiles &= tiles - 1;
    LOADT(j); WRITET(0);
    __syncthreads();
    int buf = 0;
    for (;;) {
        const bool more = tiles != 0u; int jn = 0;
        if (more) { jn = __builtin_ctz(tiles); tiles &= tiles - 1; LOADT(jn); }
        const int kb = 64 * j;
        bool act;
        if (MODE == M_SEL) act = __any((mysel >> j) & 1u);
        else if (MODE == M_WIN) act = (kb <= qhi) && (kb + 63 >= qlo - 511);
        else act = kb <= qhi;
        if (act) {
            f32x16 p0, p1;
            qkt(p0, p1, lds + L_K + buf * SHM, r32, hi, qr);
            if (MODE == M_FOX) {
#pragma unroll
                for (int rg = 0; rg < 4; ++rg) { const f32x4 b0 = *(const LAS f32x4*)(kbl + buf * 64 + 8 * rg + 4 * hi), b1 = *(const LAS f32x4*)(kbl + buf * 64 + 32 + 8 * rg + 4 * hi);
#pragma unroll
                    for (int e = 0; e < 4; ++e) { p0[4 * rg + e] = fmaf(p0[4 * rg + e], C2, b0[e]); p1[4 * rg + e] = fmaf(p1[4 * rg + e], C2, b1[e]); } }
                if (kb + 63 > qlo) mask_tile(p0, p1, qpos - 4 * hi - kb, BIGW);
            } else if (MODE == M_WIN) {
                if (kb + 63 > qlo || kb <= qhi - 512) mask_tile(p0, p1, qpos - 4 * hi - kb, 512u);
            } else {
                if (kb + 63 > qlo) mask_tile(p0, p1, qpos - 4 * hi - kb, BIGW);
                if (!((mysel >> j) & 1u)) { const float NEG = -__builtin_inff();
#pragma unroll
                    for (int r = 0; r < 16; ++r) { p0[r] = NEG; p1[r] = NEG; } }
            }
            float alpha;
            partialSM<MODE == M_FOX>(p0, p1, m_reg, alpha);
            rescale(o, alpha, al_l, r32, hi);
            bf16x8 pa0, pa1, pa2, pa3;
            finishSM(p0, p1, alpha, l_reg, pa0, pa1, pa2, pa3);
            pv_tile(o, vb0 + buf * SHM, pa0, pa1, pa2, pa3);
        }
        if (more) WRITET(buf ^ 1);
        __syncthreads();
        if (!more) break;
        j = jn; buf ^= 1;
    }
#undef LOADT
#undef WRITET
}
template <int STAGE>
__device__ __forceinline__ void fold(LAS unsigned* ofin_l, const f32x16 (&o)[4], float fac, LAS float* li_l, int r32, int hi) {
    if (hi == 0) li_l[r32] = fac; asm volatile("s_waitcnt lgkmcnt(0)" ::: "memory");
#pragma unroll
    for (int r = 0; r < 16; r += 2) { const float f0 = li_l[crow(r, hi)], f1 = li_l[crow(r + 1, hi)];
#pragma unroll
        for (int d = 0; d < 4; ++d) { float a = o[d][r] * f0, c = o[d][r + 1] * f1; LAS unsigned* sl = ofin_l + (d * 8 + (r >> 1)) * 512;
            if (STAGE == 1) { const unsigned w = *sl; a += __uint_as_float(w << 16); c += __uint_as_float(w & 0xffff0000u); }
            *sl = cvtpk(a, c); } }
    asm volatile("s_waitcnt lgkmcnt(0)" ::: "memory");
}
template <bool ROPE>
__device__ __forceinline__ void q_prep(bf16x8 (&qr)[8], const float* gain, const float* rope, int t, int hi) {
    f32x4 gg[8][2];
#pragma unroll
    for (int d0 = 0; d0 < 8; ++d0) { gg[d0][0] = *(const f32x4*)(gain + 16 * d0 + 8 * hi); gg[d0][1] = *(const f32x4*)(gain + 16 * d0 + 8 * hi + 4); }
    __builtin_amdgcn_sched_barrier(0);
    float v[8][8]; float ss = 0.f;
#pragma unroll
    for (int d0 = 0; d0 < 8; ++d0) { const u32x4 w = __builtin_bit_cast(u32x4, qr[d0]);
#pragma unroll
        for (int e = 0; e < 4; ++e) { v[d0][2 * e] = __uint_as_float(w[e] << 16); v[d0][2 * e + 1] = __uint_as_float(w[e] & 0xffff0000u); }
#pragma unroll
        for (int e = 0; e < 8; ++e) ss += v[d0][e] * v[d0][e]; }
    { auto rr = __builtin_amdgcn_permlane32_swap(__float_as_uint(ss), __float_as_uint(ss), false, false); ss = __uint_as_float(rr[0]) + __uint_as_float(rr[1]); }
    const float rstd = 1.0f / sqrtf(ss * (1.f / 128.f) + RMS_EPS);
#pragma unroll
    for (int d0 = 0; d0 < 8; ++d0) { const f32x4 g0 = gg[d0][0], g1 = gg[d0][1];
#pragma unroll
        for (int e = 0; e < 4; ++e) { v[d0][e] = v[d0][e] * rstd * g0[e]; v[d0][4 + e] = v[d0][4 + e] * rstd * g1[e]; } }
    if (ROPE) {
        const f32x4 ca = *(const f32x4*)(rope + t * 16 + 8 * hi), cb = *(const f32x4*)(rope + t * 16 + 8 * hi + 4);
        const f32x4 sa = *(const f32x4*)(rope + 2048 * 16 + t * 16 + 8 * hi), sb = *(const f32x4*)(rope + 2048 * 16 + t * 16 + 8 * hi + 4);
#pragma unroll
        for (int e = 0; e < 8; ++e) { const float cc = e < 4 ? ca[e] : cb[e - 4], sn = e < 4 ? sa[e] : sb[e - 4];
            const float x1 = v[0][e], x2 = v[1][e]; v[0][e] = x1 * cc - x2 * sn; v[1][e] = x1 * sn + x2 * cc; }
    }
#pragma unroll
    for (int d0 = 0; d0 < 8; ++d0) { u32x4 w; w.x = cvtpk(v[d0][0], v[d0][1]); w.y = cvtpk(v[d0][2], v[d0][3]); w.z = cvtpk(v[d0][4], v[d0][5]); w.w = cvtpk(v[d0][6], v[d0][7]);
        qr[d0] = __builtin_bit_cast(bf16x8, w); }
}
__device__ __forceinline__ void nsa_unit(LAS unsigned char* lds, int b, int g, int u, const bf16_t* proj, const float* small, const bf16_t* kcmp, const bf16_t* vcmp, const float* nqn, const float* rope, bf16_t* onsa, int tid, int wid, int lane) {
    const int r32 = lane & 31, hi = lane >> 5;
    const int q0 = 64 * u, tokl = 8 * wid + (r32 >> 2), qpos = q0 + tokl, qlo = q0 + 8 * wid, qhi = qlo + 7, head = g * 4 + (r32 & 3);
    const size_t row = (size_t)b * SEQ + qpos;
    LAS float* li_l = (LAS float*)(lds + L_WS) + wid * 64;
    LAS float* psum = (LAS float*)(lds + L_PSUM); LAS float* imp = (LAS float*)(lds + L_IMP); LAS unsigned* selm = (LAS unsigned*)(lds + L_SELM); LAS unsigned* un = (LAS unsigned*)(lds + L_UN);
    bf16x8 qr[8];
#pragma unroll
    for (int d0 = 0; d0 < 8; ++d0) qr[d0] = *(const bf16x8*)(proj + row * PITCH + C_NSAQ + head * 128 + d0 * 16 + hi * 8);
    q_prep<true>(qr, nqn, rope, qpos, hi);
    const float* gl = small + row * 64 + head * 3;
    const float g0 = pg8::sigm(gl[0]);
    LAS float* gate_l = (LAS float*)(lds + L_GATE) + wid * 64;
    if (hi == 0) { gate_l[r32] = pg8::sigm(gl[1]); gate_l[32 + r32] = pg8::sigm(gl[2]); }
    f32x16 o[4]; float fac0;
    LAS unsigned* ofin_l = (LAS unsigned*)(lds + L_OFIN) + tid;
    {
        const int sr = tid >> 4, sc = (tid & 15) * 8;
        const int kws = KSWZ(sr, sc * 2), vst0 = v_st(sr, sc), vst1 = v_st(32 + sr, sc);
        const bf16_t* kc = kcmp + (size_t)(b * 4 + g) * 128 * 128; const bf16_t* vc = vcmp + (size_t)(b * 4 + g) * 128 * 128;
#pragma unroll
        for (int tl = 0; tl < 2; ++tl) { const size_t ro = (size_t)(64 * tl + sr) * 128 + sc;
            const bf16x8 k0 = *(const bf16x8*)(kc + ro), k1 = *(const bf16x8*)(kc + ro + 32 * 128), v0 = *(const bf16x8*)(vc + ro), v1 = *(const bf16x8*)(vc + ro + 32 * 128);
            *(LAS bf16x8*)(lds + L_K + tl * SHM + kws) = k0; *(LAS bf16x8*)(lds + L_K + tl * SHM + kws + 32 * 256) = k1;
            *(LAS bf16x8*)(lds + L_V + tl * SHM + vst0) = v0; *(LAS bf16x8*)(lds + L_V + tl * SHM + vst1) = v1; }
        __syncthreads();
        f32x16 a0, a1, b0, b1;
        qkt(a0, a1, lds + L_K, r32, hi, qr); qkt(b0, b1, lds + L_K + SHM, r32, hi, qr);
        const int vp = (qpos - 31) >> 4;
        mask_tile(a0, a1, vp - 4 * hi, BIGW); mask_tile(b0, b1, vp - 4 * hi - 64, BIGW);
        float mx = a0[0];
#pragma unroll
        for (int r = 0; r < 16; ++r) mx = fmaxf(fmaxf(mx, a0[r]), fmaxf(a1[r], fmaxf(b0[r], b1[r])));
        { auto rr = __builtin_amdgcn_permlane32_swap(__float_as_uint(mx), __float_as_uint(mx), false, false); mx = fmaxf(__uint_as_float(rr[0]), __uint_as_float(rr[1])); }
        if (mx == -__builtin_inff()) mx = 0.f;
        const float mnL = -mx * C2; float ps = 0.f;
#pragma unroll
        for (int r = 0; r < 16; ++r) { a0[r] = __builtin_amdgcn_exp2f(fmaf(a0[r], C2, mnL)); a1[r] = __builtin_amdgcn_exp2f(fmaf(a1[r], C2, mnL));
            b0[r] = __builtin_amdgcn_exp2f(fmaf(b0[r], C2, mnL)); b1[r] = __builtin_amdgcn_exp2f(fmaf(b1[r], C2, mnL)); ps += (a0[r] + a1[r]) + (b0[r] + b1[r]); }
        { auto rr = __builtin_amdgcn_permlane32_swap(__float_as_uint(ps), __float_as_uint(ps), false, false); ps = __uint_as_float(rr[0]) + __uint_as_float(rr[1]); }
        const float rl = ps > 0.f ? 1.f / ps : 0.f;
#pragma unroll
        for (int r = 0; r < 16; ++r) { const int key = crow(r, hi);
            float v0 = a0[r] * rl, v1 = a1[r] * rl, v2 = b0[r] * rl, v3 = b1[r] * rl;
            v0 = quad_sum(v0); v1 = quad_sum(v1); v2 = quad_sum(v2); v3 = quad_sum(v3);
            if ((r32 & 3) == 0) { LAS float* pp = psum + tokl * 128 + key; pp[0] = v0; pp[32] = v1; pp[64] = v2; pp[96] = v3; } }
        bf16x8 pa0, pa1, pa2, pa3;
        const int vb0 = (int)(uintptr_t)(lds + L_V) + v_rd_base(lane);
#pragma unroll
        for (int d = 0; d < 4; ++d) o[d] = f32x16{};
        packP(a0, a1, pa0, pa1, pa2, pa3); pv_tile(o, vb0, pa0, pa1, pa2, pa3);
        packP(b0, b1, pa0, pa1, pa2, pa3); pv_tile(o, vb0 + SHM, pa0, pa1, pa2, pa3);
        fac0 = g0 * rl;
        __syncthreads();
    }
    {
        const int tk = tid >> 3, jg = tid & 7; const float NINF = -__builtin_inff();
        float sc4[4];
#pragma unroll
        for (int jj = 0; jj < 4; ++jj) { const int j = jg * 4 + jj; float im = 0.f;
#pragma unroll
            for (int i = -1; i <= 3; ++i) { const int ci = 4 * j + i; if (ci >= 0 && ci < NCMP) im += psum[tk * 128 + ci]; }
            const bool forced = (j == 0) || (j == u) || (j == u - 1); const bool causal = j <= u;
            sc4[jj] = forced ? __builtin_inff() : (causal ? im : NINF); imp[tk * 32 + j] = sc4[jj]; }
        asm volatile("s_waitcnt lgkmcnt(0)" ::: "memory");
        unsigned bits = 0u;
        f32x4 sv[8];
#pragma unroll
        for (int q = 0; q < 8; ++q) sv[q] = *(const LAS f32x4*)(imp + tk * 32 + 4 * q);
#pragma unroll
        for (int jj = 0; jj < 4; ++jj) { const int j = jg * 4 + jj; const float sj = sc4[jj]; int rank = 0;
#pragma unroll
            for (int k = 0; k < 32; ++k) { const float sk = sv[k >> 2][k & 3]; rank += (sk > sj || (sk == sj && k < j)) ? 1 : 0; }
            if (rank < 16 && sj > NINF) bits |= 1u << j; }
        bits |= __shfl_xor(bits, 1); bits |= __shfl_xor(bits, 2); bits |= __shfl_xor(bits, 4);
        if (jg == 0) selm[tk] = bits;
        unsigned ub = bits; ub |= __shfl_xor(ub, 8); ub |= __shfl_xor(ub, 16); ub |= __shfl_xor(ub, 32);
        if (lane == 0) un[wid] = ub;
        __syncthreads();
    }
    fold<0>(ofin_l, o, fac0, li_l, r32, hi);
    const unsigned mysel = selm[tokl];
    unsigned uni = 0u;
#pragma unroll
    for (int w = 0; w < 8; ++w) uni |= un[w];
    uni = __builtin_amdgcn_readfirstlane(uni);
    {
        float m_reg = -1e30f, l_reg = 0.f;
#pragma unroll
        for (int d = 0; d < 4; ++d) o[d] = f32x16{};
        const bf16_t* Kg = proj + (size_t)b * SEQ * PITCH + C_KS + g * 128; const bf16_t* Vg = proj + (size_t)b * SEQ * PITCH + C_VS + g * 128;
        attn_stream<M_SEL>(lds, Kg, Vg, uni, qr, o, m_reg, l_reg, qpos, qlo, qhi, mysel, nullptr, tid, wid, lane);
        fold<1>(ofin_l, o, l_reg > 0.f ? gate_l[r32] / l_reg : 0.f, li_l, r32, hi);
    }
    {
        float m_reg = -1e30f, l_reg = 0.f;
#pragma unroll
        for (int d = 0; d < 4; ++d) o[d] = f32x16{};
        const int jlo = u >= 8 ? u - 8 : 0;
        const unsigned tiles = (u == 31 ? 0xffffffffu : ((1u << (u + 1)) - 1u)) & ~((1u << jlo) - 1u);
        const bf16_t* Kg = proj + (size_t)b * SEQ * PITCH + C_KW + g * 128; const bf16_t* Vg = proj + (size_t)b * SEQ * PITCH + C_VW + g * 128;
        attn_stream<M_WIN>(lds, Kg, Vg, tiles, qr, o, m_reg, l_reg, qpos, qlo, qhi, 0u, nullptr, tid, wid, lane);
        if (hi == 0) li_l[r32] = l_reg > 0.f ? gate_l[32 + r32] / l_reg : 0.f; asm volatile("s_waitcnt lgkmcnt(0)" ::: "memory");
        LAS bf16_t* stg = (LAS bf16_t*)(lds + wid * 8192);
#pragma unroll
        for (int r = 0; r < 16; ++r) { const int rr = crow(r, hi); const float f = li_l[rr];
#pragma unroll
            for (int d = 0; d < 4; ++d) { const unsigned w = ofin_l[(d * 8 + (r >> 1)) * 512];
                const float v = ((r & 1) ? __uint_as_float(w & 0xffff0000u) : __uint_as_float(w << 16)) + o[d][r] * f;
                stg[rr * 128 + d * 32 + r32] = (bf16_t)cvtpk(v, 0.f); } }
        asm volatile("s_waitcnt lgkmcnt(0)" ::: "memory");
#pragma unroll
        for (int i = 0; i < 8; ++i) { const int rr = i * 4 + (lane >> 4), ch = lane & 15;
            const u32x4 w = *(const LAS u32x4*)(stg + rr * 128 + ch * 8);
            *(u32x4*)(onsa + ((size_t)b * SEQ + q0 + 8 * wid + (rr >> 2)) * 2048 + (g * 4 + (rr & 3)) * 128 + ch * 8) = w; }
        asm volatile("s_waitcnt lgkmcnt(0)" ::: "memory");
    }
}
__device__ __forceinline__ void fox_unit(LAS unsigned char* lds, int b, int h, int qb, const bf16_t* proj, const float* cum, const float* fqn, const float* fkn, bf16_t* ofox, int tid, int wid, int lane) {
    const int r32 = lane & 31, hi = lane >> 5;
    const int q0 = 256 * qb, qlo = q0 + 32 * wid, qpos = qlo + r32, qhi = qlo + 31;
    const size_t row = (size_t)b * SEQ + qpos;
    LAS float* li_l = (LAS float*)(lds + L_WS) + wid * 64;
    bf16x8 qr[8];
#pragma unroll
    for (int d0 = 0; d0 < 8; ++d0) qr[d0] = *(const bf16x8*)(proj + row * PITCH + C_FQ + h * 128 + d0 * 16 + hi * 8);
    q_prep<false>(qr, fqn, nullptr, 0, hi);
    f32x16 o[4];
#pragma unroll
    for (int d = 0; d < 4; ++d) o[d] = f32x16{};
    float m_reg = -1e30f, l_reg = 0.f;
    const int nt = 4 * (qb + 1);
    const float* cumrow = cum + (size_t)(b * 16 + h) * SEQ;
    unsigned tiles;
    { float gq = fmaxf(fabsf(fqn[lane]), fabsf(fqn[lane + 64])), gk = fmaxf(fabsf(fkn[lane]), fabsf(fkn[lane + 64]));
      gq = wave_max(gq); gk = wave_max(gk);
      const float bound = 2.f * 128.f * 1.02f * gq * gk * C2 + 170.f;
      const int j = lane & 31; const float gap = (j < nt) ? (cumrow[64 * j + 63] - cumrow[q0]) * LOG2E : 0.f;
      tiles = (unsigned)__ballot((j < nt) && !(gap > bound)); }
    tiles = (unsigned)__builtin_amdgcn_readfirstlane((int)tiles);
    const bf16_t* Kg = proj + (size_t)b * SEQ * PITCH + C_FK + h * 128; const bf16_t* Vg = proj + (size_t)b * SEQ * PITCH + C_FV + h * 128;
    attn_stream<M_FOX>(lds, Kg, Vg, tiles, qr, o, m_reg, l_reg, qpos, qlo, qhi, 0u, cumrow, tid, wid, lane);
    if (hi == 0) li_l[r32] = l_reg > 0.f ? 1.f / l_reg : 0.f; asm volatile("s_waitcnt lgkmcnt(0)" ::: "memory");
    LAS bf16_t* stg = (LAS bf16_t*)(lds + wid * 8192);
#pragma unroll
    for (int r = 0; r < 16; ++r) { const int rr = crow(r, hi); const float f = li_l[rr];
#pragma unroll
        for (int d = 0; d < 4; ++d) stg[rr * 128 + d * 32 + r32] = (bf16_t)cvtpk(o[d][r] * f, 0.f); }
    asm volatile("s_waitcnt lgkmcnt(0)" ::: "memory");
#pragma unroll
    for (int i = 0; i < 8; ++i) { const int rr = i * 4 + (lane >> 4), ch = lane & 15;
        const u32x4 w = *(const LAS u32x4*)(stg + rr * 128 + ch * 8);
        *(u32x4*)(ofox + ((size_t)b * SEQ + qlo + rr) * 2048 + h * 128 + ch * 8) = w; }
    asm volatile("s_waitcnt lgkmcnt(0)" ::: "memory");
}
#undef KSWZ
}

__device__ __forceinline__ int fresh_lane() { int l; asm volatile("v_mbcnt_lo_u32_b32 %0, -1, 0\n\tv_mbcnt_hi_u32_b32 %0, -1, %0" : "=v"(l)); return l; }

#ifndef PROBE_DUP
#define PROBE_DUP -1
#endif
#define REPS(k) for (int rep_ = 0; rep_ < ((PROBE_DUP == (k)) ? 2 : 1); ++rep_)
#define REP_SEAM(k) do { if (PROBE_DUP == (k) && rep_ == 0) { FRESH(); xcd_barrier(bar, tid); } } while (0)

struct Args { const float* in[23]; float* out; unsigned char* ws; int ph_lo, ph_hi, li, pad; };

__global__ void __launch_bounds__(NWAVES * 64, 2) mega_fwd(Args args) {
    extern __shared__ __attribute__((aligned(16))) unsigned char lds_raw[];
    LAS unsigned char* lds = (LAS unsigned char*)lds_raw;
    volatile LAS unsigned* MISC = (volatile LAS unsigned*)(lds + MISC_OFF);
    const int wave = __builtin_amdgcn_readfirstlane((int)threadIdx.x >> 6);
#define FRESH() const int lane = fresh_lane(); const int tid = wave * 64 + lane; (void)lane; (void)tid
    const int G = gridDim.x; const int bx = blockIdx.x; const int vcu = (G % 8 == 0) ? (bx % 8) * (G / 8) + bx / 8 : bx;
    unsigned char* ws = args.ws;
    gu32* ctl = (gu32*)(ws + WS_CTL);
    const float* x = args.in[0]; const float* c = args.in[1]; const float* w_ada = args.in[2]; const float* b_ada = args.in[3];
    const float* norm1_g = args.in[4]; const float* norm2_g = args.in[5]; const float* w_in = args.in[6];
    const float* b_forget = args.in[7]; const float* nsa_q_norm = args.in[8]; const float* nsa_k_norm = args.in[9]; const float* fox_q_norm = args.in[10]; const float* fox_k_norm = args.in[11];
    const float* w_cmp_k2 = args.in[15]; const float* w_cmp_v2 = args.in[17];
    const float* cmp_pos_k = args.in[12]; const float* cmp_pos_v = args.in[13]; const float* w_cmp_k1 = args.in[14]; const float* w_cmp_v1 = args.in[16];
    const float* w_up_nsa = args.in[18]; const float* w_up_fox = args.in[19]; const float* w_out = args.in[20]; const float* w_ff1 = args.in[21]; const float* w_ff2 = args.in[22];
    float* out = args.out;
    float* mod = (float*)(ws + WS_MOD); float* c1 = (float*)(ws + WS_C1); float* rope = (float*)(ws + WS_ROPE); float* small = (float*)(ws + WS_SMALL);
    float* ssq = (float*)(ws + WS_SS); float* cbv = (float*)(ws + WS_CB);
    bf16_t* H = (bf16_t*)(ws + WS_H); bf16_t* onsa = (bf16_t*)(ws + WS_ONSA); bf16_t* ofox = (bf16_t*)(ws + WS_OFOX);
    bf16_t* Y = (bf16_t*)(ws + WS_Y); bf16_t* proj = (bf16_t*)(ws + WS_PROJ); bf16_t* Abuf = (bf16_t*)(ws + WS_A);
    bf16_t* WIN_T = (bf16_t*)(ws + WS_WIN_T); bf16_t* WUPA_T = (bf16_t*)(ws + WS_WUPA_T); bf16_t* WUPB_T = (bf16_t*)(ws + WS_WUPB_T);
    bf16_t* WC1K_T = (bf16_t*)(ws + WS_WC1K_T); bf16_t* WC1V_T = (bf16_t*)(ws + WS_WC1V_T); bf16_t* WC2K_T = (bf16_t*)(ws + WS_WC2K_T); bf16_t* WC2V_T = (bf16_t*)(ws + WS_WC2V_T);
    bf16_t* kcmp = (bf16_t*)(ws + WS_KCMP); bf16_t* vcmp = (bf16_t*)(ws + WS_VCMP); float* cum = (float*)(ws + WS_CUM);
    bf16_t* WOUT_T = (bf16_t*)(ws + WS_WOUT_T); bf16_t* WFF1_T = (bf16_t*)(ws + WS_WFF1_T); bf16_t* WFF2_T = (bf16_t*)(ws + WS_WFF2_T);

    XcdBarrier bar;
    { FRESH(); for (int u = tid; u < (LDS_BYTES - MISC_OFF) / 4; u += NWAVES * 64) ((LAS unsigned*)(lds + MISC_OFF))[u] = 0u;
      __syncthreads();
      bar = xcd_barrier_post((unsigned*)(ctl + CW_BAR) + args.li * XCD_BAR_WORDS, MISC + 8, tid); }
    const int lo = args.ph_lo, hi = args.ph_hi;
    const int nshort = (G - ((M / 256) * (PITCH / 256)) % G) % G;
    const int nbt0_ = (nshort * NWAVES * CONV_KT < TI_FF1_0) ? nshort * NWAVES * CONV_KT : TI_FF1_0; const int nbt = nbt0_ & ~255;
    const int nconv = (TI_B - nbt + 127) / 128;
#define IN(k) (lo <= (k) && (k) < hi)
#define SEAM(k) do { if (IN(k) && IN((k) + 1)) { FRESH(); xcd_barrier(bar, tid); } } while (0)

    if (IN(0)) { FRESH();
        float* red = (float*)lds_raw;
        for (int u = bx; u < 96 * 8; u += G) adaln_unit(u, c, w_ada, b_ada, mod, red, red + 8 * 4 * 256);
        const int gid = vcu * 512 + tid;
        if (gid < 2048 * 16) {
            const int pos = gid >> 4, i = gid & 15;
            double f = 1.0; for (int k = 0; k < i; ++k) f *= 0.44036660267178046;
            const float inv = (float)f; const float ang = (float)pos * inv;
            float s_, c_; sincos_turns((double)ang * 0.15915494309189533577, s_, c_);
            rope[gid] = c_; rope[2048 * 16 + gid] = s_;
        }
        if (gid < 2 * 32 * 128) {
            const int j = gid & 127, kc = (gid >> 7) & 31, which = gid >> 12;
            const float* pos = which ? cmp_pos_v : cmp_pos_k; const float* w = which ? w_cmp_v1 : w_cmp_k1;
            float a = 0.f;
            for (int k = kc * 128; k < kc * 128 + 128; ++k) a += pos[k] * w[(size_t)k * 128 + j];
            atomicAdd(c1 + which * 128 + j, a);
        }
    }
    SEAM(0);
    if (IN(1)) REPS(1) { FRESH();
        const int gw = vcu * NWAVES + wave, NGW = G * NWAVES;
        for (int row = gw; row < M; row += NGW) { const int b = row / SEQ;
            norm_mod_row(x + (size_t)row * DM, norm1_g, mod + b * 24576 + 1 * DM, mod + b * 24576 + 0 * DM, H + (size_t)row * DM, lane); }
        LAS float* scr = (LAS float*)(lds + wave * (64 * 65 * 4));
        { const DecA da{w_in, w_cmp_k1, w_cmp_v1, w_cmp_k2, w_cmp_v2, WIN_T, WC1K_T, WC1V_T, WC2K_T, WC2V_T}; tr_run(da, gw, NGW, TI_A, scr, lane); }
    REP_SEAM(1); }
    SEAM(1);
    if (IN(2)) REPS(2) { FRESH();
        pg8::Gemm g{H, WIN_T, M, PITCH, DM}; pg8::StaticOrder S; S.init(M, PITCH, G, bx);
        pg8::EpiProjF E{proj, small};
        pg8::gemm_phase<pg8::EpiProjF, pg8::StaticOrder, true, true>(lds, g, S, E, tid);
        if (PROBE_DUP != 2 || rep_ == 0) {
        if (nshort > 0 && bx >= G - nshort) {
            const DecB db{ConvB{w_up_nsa, w_up_fox, w_out, w_ff1, w_ff2, WUPA_T, WUPB_T, WOUT_T, WFF1_T, WFF2_T, cbv}};
            const int lane2 = fresh_lane(); LAS float* scr = (LAS float*)(lds + wave * (64 * 65 * 4));
            tr_run(db, (bx - (G - nshort)) * NWAVES + wave, nshort * NWAVES, nbt, scr, lane2);
        } }
    REP_SEAM(2); }
    SEAM(2);
    if (IN(3)) { FRESH();
        float* PB = (float*)(ws + WS_Y);
        const int gw = bx * NWAVES + wave, NGW = G * NWAVES;
        for (int id = gw; id < 32 * 64; id += NGW) compress_s1(id, proj, WC1K_T, WC1V_T, PB, lane);
        { FRESH(); xcd_barrier(bar, tid); }
        const int ncb = G > 64 ? 32 : 0;
        if (ncb == 0 || bx < ncb)
            for (int cu = bx; cu < 32; cu += (ncb ? ncb : G)) { const int which = cu >> 4;
                compress_s2(which, PB + (size_t)(cu * 2) * 128 * 128, PB + (size_t)(cu * 2 + 1) * 128 * 128, which ? WC2V_T : WC2K_T, c1 + which * 128, nsa_k_norm, rope,
                            (which ? vcmp : kcmp) + (size_t)(cu & 15) * 128 * 128, wave, lane); }
        if (ncb && bx < ncb) { if (wave < 2) cumsum_bh(bx * 2 + wave, small, b_forget, cum, lane); }
        if (bx >= ncb) {
            const int gw2 = (bx - ncb) * NWAVES + wave, NGW2 = (G - ncb) * NWAVES;
            if (!ncb) for (int bh = gw2; bh < 64; bh += NGW2) cumsum_bh(bh, small, b_forget, cum, lane);
            for (int row = gw2; row < M; row += NGW2) post_row(proj, row, nsa_q_norm, nsa_k_norm, fox_q_norm, fox_k_norm, rope, lane);
        }
    }
    SEAM(3);
    if (IN(4)) REPS(4) { FRESH();
        LAS unsigned* qslot = (LAS unsigned*)(lds + att::L_Q);
        const unsigned ncp = (unsigned)(nconv < 256 ? nconv : 256), nc3 = 5u * ncp, qend = 1024u + (unsigned)nconv;
        for (;;) {
            if (tid == 0) *qslot = __hip_atomic_fetch_add((unsigned*)(ctl + CW_QUEUE + 128 * rep_), 1u, __ATOMIC_RELAXED, __HIP_MEMORY_SCOPE_AGENT);
            __syncthreads();
            const unsigned idx = (unsigned)__builtin_amdgcn_readfirstlane((int)*qslot);
            __syncthreads();
            if (idx >= qend) break;
            int cu = -1, a = -1;
            if (idx < nc3) { const unsigned p3 = idx / 5u, r3 = idx - 5u * p3; if (r3 == 4u) cu = (int)p3; else a = (int)(4u * p3 + r3); }
            else if (nconv <= 256) a = (int)(idx - (unsigned)nconv);
            else cu = (int)(idx - 1024u);
            if (cu >= 0) {
                if (PROBE_DUP != 4 || rep_ == 0) {
                    const DecB db{ConvB{w_up_nsa, w_up_fox, w_out, w_ff1, w_ff2, WUPA_T, WUPB_T, WOUT_T, WFF1_T, WFF2_T, cbv}};
                    const int laneC = fresh_lane(); LAS float* scr = (LAS float*)(lds + wave * (64 * 65 * 4));
                    const int i0 = nbt + cu * 128, e0 = i0 + 128; LAS float* shl = (LAS float*)(lds + 8 * (64 * 65 * 4));
                    const bool ff1u = i0 >= TI_FF1_0;
                    if (ff1u) { const int tC = wave * 64 + laneC; if (tC < 256) shl[tC] = mod[(size_t)(tC >> 6) * 24576 + 3 * DM + 64 * ((i0 - TI_FF1_0) / 256) + (tC & 63)]; __syncthreads(); }
                    tr_run(db, i0 + wave, 8, e0 < TI_B ? e0 : TI_B, scr, laneC, ff1u ? shl : (LAS float*)nullptr);
                }
            } else {
                const int k = a >> 1;
                if ((a & 1) == 0) { const int laneA = fresh_lane(), tidA = wave * 64 + laneA; const int u = 31 - (k >> 4), bg = k & 15;
                    att::nsa_unit(lds, bg >> 2, bg & 3, u, proj, small, kcmp, vcmp, nsa_q_norm, rope, onsa, tidA, wave, laneA); }
                else { const int laneB = fresh_lane(), tidB = wave * 64 + laneB; const int qb = 7 - (k >> 6), bh = k & 63;
                    att::fox_unit(lds, bh >> 4, bh & 15, qb, proj, cum, fox_q_norm, fox_k_norm, ofox, tidB, wave, laneB); }
            }
            __syncthreads();
        }
    REP_SEAM(4); }
    SEAM(4);
    if (IN(5)) REPS(5) { FRESH();
        static_assert(WS_OFOX == WS_ONSA + (size_t)M * 2048 * 2 && WS_WUPB_T == WS_WUPA_T + (size_t)DM * 2048 * 2, "the stacked operands are contiguous");
        pg8::UpOrder S; S.base.init(M, DM, G, bx);
        pg8::Gemm g{onsa, WUPA_T, 2 * M, 2 * DM, 2048}; pg8::EpiUpCat E{proj, Y};
        pg8::gemm_phase<pg8::EpiUpCat, pg8::UpOrder, true, true>(lds, g, S, E, tid);
    REP_SEAM(5); }
    SEAM(5);
    if (IN(6)) REPS(6) { FRESH();
        pg8::Gemm g{Y, WOUT_T, M, DM, DM}; pg8::StaticOrder S; S.init(M, DM, G, bx);
        pg8::EpiResNormF E{x, mod + 2 * DM, out, norm2_g, mod + 4 * DM, H, ssq};
        pg8::gemm_phase<pg8::EpiResNormF, pg8::StaticOrder, true, true>(lds, g, S, E, tid);
    REP_SEAM(6); }
    SEAM(6);
    if (IN(8)) REPS(8) { FRESH();
        pg8::Gemm g{H, WFF1_T, M, DFF, DM}; pg8::StaticOrder S; S.init(M, DFF, G, bx);
        pg8::EpiFF1NF E{Abuf, ssq, cbv};
        pg8::gemm_phase<pg8::EpiFF1NF, pg8::StaticOrder, true, true>(lds, g, S, E, tid);
    REP_SEAM(8); }
    SEAM(8);
    if (IN(9)) { FRESH();
        pg8::Gemm g{Abuf, WFF2_T, M, DM, DFF}; pg8::StaticOrder S; S.init(M, DM, G, bx);
        pg8::EpiResF E{out, mod + 5 * DM, out};
        pg8::gemm_phase<pg8::EpiResF, pg8::StaticOrder, true, true>(lds, g, S, E, tid);
    }
#undef IN
#undef SEAM
}

extern "C" void kernel_launch(void* const* d_in, const int* in_sizes, int n_in, void* d_out, int out_size, void* d_ws, size_t ws_size, hipStream_t stream) {
    static int grid = 0;
    if (grid == 0) {
        if (n_in != 23 || out_size != M * DM || ws_size < WS_END) { fprintf(stderr, "kernel_launch: unexpected shapes (n_in %d out %d ws %zu)\n", n_in, out_size, ws_size); grid = -1; return; }
        int dev = 0, cus = 0, per_cu = 0;
        if (hipGetDevice(&dev) != hipSuccess || hipDeviceGetAttribute(&cus, hipDeviceAttributeMultiprocessorCount, dev) != hipSuccess) { grid = -1; return; }
        if (hipFuncSetAttribute((const void*)mega_fwd, hipFuncAttributeMaxDynamicSharedMemorySize, LDS_BYTES) != hipSuccess) { fprintf(stderr, "kernel_launch: hipFuncSetAttribute failed\n"); grid = -1; return; }
        if (hipOccupancyMaxActiveBlocksPerMultiprocessor(&per_cu, (const void*)mega_fwd, NWAVES * 64, LDS_BYTES) != hipSuccess || per_cu < 1) fprintf(stderr, "kernel_launch: occupancy query says %d\n", per_cu);
        (void)hipGetLastError();
        grid = cus;
    }
    if (grid < 0) return;
    const float* x = (const float*)d_in[0];
    const float* b_forget = (const float*)d_in[7];
    const float* nsa_q_norm = (const float*)d_in[8]; const float* nsa_k_norm = (const float*)d_in[9]; const float* fox_q_norm = (const float*)d_in[10]; const float* fox_k_norm = (const float*)d_in[11];
    const float* w_cmp_k1 = (const float*)d_in[14]; const float* w_cmp_k2 = (const float*)d_in[15];
    const float* w_cmp_v1 = (const float*)d_in[16]; const float* w_cmp_v2 = (const float*)d_in[17];
    unsigned char* ws = (unsigned char*)d_ws; (void)x;
    float* c1 = (float*)(ws + WS_C1); float* rope = (float*)(ws + WS_ROPE); float* small = (float*)(ws + WS_SMALL); float* cum = (float*)(ws + WS_CUM);
    bf16_t* kcmp = (bf16_t*)(ws + WS_KCMP); bf16_t* vcmp = (bf16_t*)(ws + WS_VCMP); bf16_t* onsa = (bf16_t*)(ws + WS_ONSA); bf16_t* ofox = (bf16_t*)(ws + WS_OFOX);
    bf16_t* proj = (bf16_t*)(ws + WS_PROJ);

    (void)hipMemsetAsync(ws + WS_CTL, 0, WS_ZERO_BYTES, stream);
    Args a{};
    for (int i = 0; i < 23; ++i) a.in[i] = (const float*)d_in[i];
    a.out = (float*)d_out; a.ws = ws;
    a.ph_lo = 0; a.ph_hi = 10; a.li = 0;
    hipLaunchKernelGGL(mega_fwd, dim3(grid), dim3(NWAVES * 64), LDS_BYTES, stream, a);
}
```

```cpp
#include <hip/hip_runtime.h>
#include <stdint.h>
#include <stdio.h>

typedef unsigned short bf16_t;
typedef float f32x4 __attribute__((ext_vector_type(4)));
typedef unsigned u32x4 __attribute__((ext_vector_type(4)));
typedef unsigned u32x2 __attribute__((ext_vector_type(2)));

constexpr int BATCH = 4, SEQ = 2048, DM = 4096, M = BATCH * SEQ;
constexpr int HD = 128, NH = 16, NG = 4, DFF = 16384;
constexpr int NCMP = 127;
constexpr float ATT_SCALE = 0.08838834764831845f;
constexpr float RMS_EPS = 1e-6f;
constexpr int PITCH = 19712, N_IN = 19520, N_IN_OLD = 19520;
constexpr int C_NSAQ = 0, C_NSAKV = 2048, C_FOX = 5120, C_MERGE = 11264, C_SMALL = 19456;
constexpr int C_KC = C_NSAKV + 0 * 128 * 4, C_VC = C_NSAKV + 1 * 512, C_KS = C_NSAKV + 2 * 512, C_VS = C_NSAKV + 3 * 512, C_KW = C_NSAKV + 4 * 512, C_VW = C_NSAKV + 5 * 512;
constexpr int C_FQ = C_FOX, C_FK = C_FOX + 2048, C_FV = C_FOX + 4096;
constexpr int C_GA = C_MERGE, C_GB = C_MERGE + 4096;

constexpr size_t KiB = 1024, MiB = 1024 * 1024;
constexpr size_t WS_CTL = 0, WS_ZERO_BYTES = 1 * MiB;
constexpr size_t WS_MOD = 256 * KiB;
constexpr size_t WS_C1 = 640 * KiB;
constexpr size_t WS_SS = 704 * KiB;
constexpr size_t WS_CB = 768 * KiB;
constexpr size_t WS_ROPE = 1 * MiB;
constexpr size_t WS_SMALL = 2 * MiB;
constexpr size_t WS_CUM = 4 * MiB;
constexpr size_t WS_KCMP = 5 * MiB, WS_VCMP = 5 * MiB + 512 * KiB;
constexpr size_t WS_WC2K_T = 1 * MiB + 512 * KiB, WS_WC2V_T = 1 * MiB + 576 * KiB;
constexpr size_t WS_WC1K_T = 6 * MiB, WS_WC1V_T = 7 * MiB;
constexpr size_t WS_H = 8 * MiB;
constexpr size_t WS_ONSA = 72 * MiB, WS_OFOX = 104 * MiB;
constexpr size_t WS_Y = 136 * MiB;
constexpr size_t WS_PROJ = 200 * MiB;
constexpr size_t WS_A = WS_PROJ;
constexpr size_t WS_END = 992 * MiB;

__device__ __forceinline__ float bf2f(bf16_t v) { return __uint_as_float(((unsigned)v) << 16); }
__device__ __forceinline__ bf16_t f2bf(float f) { unsigned u = __float_as_uint(f); return (bf16_t)((u + 0x7fffu + ((u >> 16) & 1u)) >> 16); }
__device__ __forceinline__ float rbf(float f) { return bf2f(f2bf(f)); }
__device__ __forceinline__ float sigmoidf_(float x) { return 1.f / (1.f + __expf(-x)); }
__device__ __forceinline__ float wave_sum(float v) {
#pragma unroll
    for (int o = 1; o < 64; o <<= 1) v += __shfl_xor(v, o);
    return v;
}
__device__ __forceinline__ float wave_max(float v) {
#pragma unroll
    for (int o = 1; o < 64; o <<= 1) v = fmaxf(v, __shfl_xor(v, o));
    return v;
}

__device__ __forceinline__ void sincos_turns(double turns, float& s, float& c) {
    double fr = turns - floor(turns);
    double q = floor(fr * 4.0 + 0.5);
    double r = fr - q * 0.25;
    double x = r * 6.283185307179586476925;
    double x2 = x * x;
    double sn = x * (1.0 + x2 * (-1.0 / 6 + x2 * (1.0 / 120 + x2 * (-1.0 / 5040 + x2 * (1.0 / 362880 + x2 * (-1.0 / 39916800 + x2 * (1.0 / 6227020800.0)))))));
    double cs = 1.0 + x2 * (-0.5 + x2 * (1.0 / 24 + x2 * (-1.0 / 720 + x2 * (1.0 / 40320 + x2 * (-1.0 / 3628800 + x2 * (1.0 / 479001600.0 + x2 * (-1.0 / 87178291200.0)))))));
    int qi = ((int)q) & 3;
    double so = qi == 0 ? sn : qi == 1 ? cs : qi == 2 ? -sn : -cs;
    double co = qi == 0 ? cs : qi == 1 ? -sn : qi == 2 ? -cs : sn;
    s = (float)so; c = (float)co;
}
__global__ __launch_bounds__(256) void k_prep(float* rope, float* c1, const float* pos_k, const float* pos_v, const float* w1k, const float* w1v) {
    const int gid = blockIdx.x * 256 + threadIdx.x;
    if (gid < 2048 * 16) {
        const int pos = gid >> 4, i = gid & 15;
        double f = 1.0; for (int k = 0; k < i; ++k) f *= 0.44036660267178046;
        const float inv = (float)f;
        const float ang = (float)pos * inv;
        float s, c; sincos_turns((double)ang * 0.15915494309189533577, s, c);
        rope[gid] = c; rope[2048 * 16 + gid] = s;
    }
    if (gid < 2 * 32 * 128) {
        const int j = gid & 127, kc = (gid >> 7) & 31, which = gid >> 12;
        const float* pos = which ? pos_v : pos_k; const float* w = which ? w1v : w1k;
        float a = 0.f;
        for (int k = kc * 128; k < kc * 128 + 128; ++k) a += pos[k] * w[(size_t)k * 128 + j];
        atomicAdd(c1 + which * 128 + j, a);
    }
}

__device__ __forceinline__ void adaln_unit(int unit, const float* c, const float* w_ada, const float* b_ada, float* mod, float* red  , float* sil  ) {
    const int tid = threadIdx.x, lane = tid & 63, wave = tid >> 6;
    const int cc = unit % 96, kc = unit / 96;
    { const int k = kc * 512 + tid; f32x4 s4;
#pragma unroll
      for (int b = 0; b < 4; ++b) { const float cv = c[b * DM + k]; s4[b] = cv * __builtin_amdgcn_rcpf(1.f + __expf(-cv)); }
      *(f32x4*)(sil + 4 * tid) = s4; }
    __syncthreads();
    const int col0 = cc * 256 + lane * 4;
    float acc[4][4];
#pragma unroll
    for (int b = 0; b < 4; ++b)
#pragma unroll
        for (int j = 0; j < 4; ++j) acc[b][j] = 0.f;
    const int k0 = kc * 512 + wave * 64;
#pragma unroll 16
    for (int r = 0; r < 64; ++r) {
        const int k = k0 + r;
        const f32x4 w = *(const f32x4*)(w_ada + (size_t)k * 24576 + col0);
        const f32x4 s4 = *(const f32x4*)(sil + 4 * (wave * 64 + r));
#pragma unroll
        for (int b = 0; b < 4; ++b) { const float s = s4[b];
            acc[b][0] += s * w[0]; acc[b][1] += s * w[1]; acc[b][2] += s * w[2]; acc[b][3] += s * w[3]; }
    }
#pragma unroll
    for (int b = 0; b < 4; ++b)
#pragma unroll
        for (int j = 0; j < 4; ++j) red[(wave * 4 + b) * 256 + lane * 4 + j] = acc[b][j];
    __syncthreads();
    for (int e = tid; e < 1024; e += 512) {
        const int b = e >> 8, cl = e & 255; float s = 0.f;
#pragma unroll
        for (int w = 0; w < 8; ++w) s += red[(w * 4 + b) * 256 + cl];
        if (kc == 0) s += b_ada[cc * 256 + cl];
        atomicAdd(mod + b * 24576 + cc * 256 + cl, s);
    }
    __syncthreads();
}
__global__ __launch_bounds__(512) void k_adaln(const float* c, const float* w_ada, const float* b_ada, float* mod) {
    __shared__ float red[8 * 4 * 256]; __shared__ float sil[512 * 4];
    for (int u = blockIdx.x; u < 96 * 8; u += gridDim.x) adaln_unit(u, c, w_ada, b_ada, mod, red, sil);
}

__device__ __forceinline__ void norm_mod_row(const float* xrow, const float* g, const float* scale, const float* shift, bf16_t* orow, int lane) {
    f32x4 v[16]; float ss = 0.f;
#pragma unroll
    for (int j = 0; j < 16; ++j) { v[j] = *(const f32x4*)(xrow + 256 * j + 4 * lane); ss += (v[j][0] * v[j][0] + v[j][1] * v[j][1]) + (v[j][2] * v[j][2] + v[j][3] * v[j][3]); }
    ss = wave_sum(ss);
    const float rstd = 1.0f / sqrtf(ss * (1.f / DM) + RMS_EPS);
#pragma unroll
    for (int jb = 0; jb < 16; jb += 4) {
        f32x4 gg[4], sc[4], sh[4];
#pragma unroll
        for (int jj = 0; jj < 4; ++jj) { const int col = 256 * (jb + jj) + 4 * lane; gg[jj] = *(const f32x4*)(g + col); sc[jj] = *(const f32x4*)(scale + col); sh[jj] = *(const f32x4*)(shift + col); }
#pragma unroll
        for (int jj = 0; jj < 4; ++jj) { const int j = jb + jj; const int col = 256 * j + 4 * lane;
            float o[4];
#pragma unroll
            for (int e = 0; e < 4; ++e) o[e] = (v[j][e] * rstd * gg[jj][e]) * (1.f + sc[jj][e]) + sh[jj][e];
            u32x2 w; asm("v_cvt_pk_bf16_f32 %0, %1, %2" : "=v"(w.x) : "v"(o[0]), "v"(o[1])); asm("v_cvt_pk_bf16_f32 %0, %1, %2" : "=v"(w.y) : "v"(o[2]), "v"(o[3]));
            *(u32x2*)(orow + col) = w; }
    }
}
__global__ __launch_bounds__(256) void k_norm_mod(const float* x, const float* g, const float* mod, int shift_idx, int scale_idx, bf16_t* H) {
    const int lane = threadIdx.x & 63, gw = (blockIdx.x * 256 + threadIdx.x) >> 6, nw = (gridDim.x * 256) >> 6;
    for (int row = gw; row < M; row += nw) {
        const int b = row / SEQ;
        norm_mod_row(x + (size_t)row * DM, g, mod + b * 24576 + scale_idx * DM, mod + b * 24576 + shift_idx * DM, H + (size_t)row * DM, lane);
    }
}

struct MapIdent { __device__ __forceinline__ int operator()(int n) const { return n; } };
struct MapInProj {
    __device__ __forceinline__ int operator()(int n) const {
        if (n < 5120) return n;
        if (n < 11264) return n - 5120 + 5168;
        if (n < 19456) return n - 11264 + 11328;
        if (n < 19504) return n - 19456 + 5120;
        return n - 19504 + 11312;
    }
};
struct EpiProj { bf16_t* proj; float* small;
    __device__ __forceinline__ void operator()(int row, int col, float v) const {
        if (col < C_SMALL) proj[(size_t)row * PITCH + col] = f2bf(v); else small[(size_t)row * 64 + (col - C_SMALL)] = v; } };
struct EpiUpA { const bf16_t* proj; bf16_t* y;
    __device__ __forceinline__ void operator()(int row, int col, float v) const {
        const float g = sigmoidf_(bf2f(proj[(size_t)row * PITCH + C_GA + col])); y[(size_t)row * DM + col] = f2bf(g * v); } };
struct EpiUpB { const bf16_t* proj; bf16_t* y;
    __device__ __forceinline__ void operator()(int row, int col, float v) const {
        const float g = sigmoidf_(bf2f(proj[(size_t)row * PITCH + C_GB + col])); y[(size_t)row * DM + col] = f2bf(bf2f(y[(size_t)row * DM + col]) + g * v); } };
struct EpiOut { const float* x; const float* mod; float* x1;
    __device__ __forceinline__ void operator()(int row, int col, float v) const {
        const int b = row / SEQ; x1[(size_t)row * DM + col] = x[(size_t)row * DM + col] + mod[b * 24576 + 2 * DM + col] * v; } };
struct EpiFF1 { bf16_t* a;
    __device__ __forceinline__ void operator()(int row, int col, float v) const { const float r = fmaxf(v, 0.f); a[(size_t)row * DFF + col] = f2bf(r * r); } };
struct EpiFF2 { const float* mod; float* out;
    __device__ __forceinline__ void operator()(int row, int col, float v) const {
        const int b = row / SEQ; out[(size_t)row * DM + col] = out[(size_t)row * DM + col] + mod[b * 24576 + 5 * DM + col] * v; } };

template <class Epi> struct GemmNaiveArgs { const bf16_t* A; const float* W; int ldw, N, K, pad; Epi epi; };
template <class BMap, class Epi>
__global__ __launch_bounds__(256) void k_gemm_naive(GemmNaiveArgs<Epi> ga) {
    const bf16_t* A = ga.A; const float* W = ga.W; const int ldw = ga.ldw, N = ga.N, K = ga.K; const BMap bmap; const Epi& epi = ga.epi;
    __shared__ float As[16][132];
    __shared__ float Bs[16][132];
    const int tid = threadIdx.x, tx = tid & 15, ty = tid >> 4;
    const int m0 = blockIdx.y * 128, n0 = blockIdx.x * 128;
    float acc[8][8];
#pragma unroll
    for (int i = 0; i < 8; ++i)
#pragma unroll
        for (int j = 0; j < 8; ++j) acc[i][j] = 0.f;
    const int arow = tid >> 1, akof = (tid & 1) * 8;
    const int bk = tid >> 4, bn = (tid & 15) * 4;
    for (int k0 = 0; k0 < K; k0 += 16) {
        { const u32x4 raw = *(const u32x4*)(A + (size_t)(m0 + arow) * K + k0 + akof);
#pragma unroll
          for (int e = 0; e < 4; ++e) { As[akof + 2 * e][arow] = __uint_as_float(raw[e] << 16); As[akof + 2 * e + 1][arow] = __uint_as_float(raw[e] & 0xffff0000u); } }
#pragma unroll
        for (int hh = 0; hh < 2; ++hh) { const int cn = n0 + bn + 64 * hh; f32x4 w = {0.f, 0.f, 0.f, 0.f};
            if (cn < N) w = *(const f32x4*)(W + (size_t)(k0 + bk) * ldw + bmap(cn));
            Bs[bk][bn + 64 * hh + 0] = rbf(w[0]); Bs[bk][bn + 64 * hh + 1] = rbf(w[1]); Bs[bk][bn + 64 * hh + 2] = rbf(w[2]); Bs[bk][bn + 64 * hh + 3] = rbf(w[3]); }
        __syncthreads();
#pragma unroll
        for (int kk = 0; kk < 16; ++kk) {
            float a[8], b[8];
#pragma unroll
            for (int i = 0; i < 4; ++i) { a[i] = As[kk][ty * 4 + i]; a[4 + i] = As[kk][64 + ty * 4 + i]; b[i] = Bs[kk][tx * 4 + i]; b[4 + i] = Bs[kk][64 + tx * 4 + i]; }
#pragma unroll
            for (int i = 0; i < 8; ++i)
#pragma unroll
                for (int j = 0; j < 8; ++j) acc[i][j] += a[i] * b[j];
        }
        __syncthreads();
    }
#pragma unroll
    for (int i = 0; i < 8; ++i) { const int row = m0 + (i < 4 ? ty * 4 + i : 64 + ty * 4 + i - 4);
#pragma unroll
        for (int j = 0; j < 8; ++j) { const int col = n0 + (j < 4 ? tx * 4 + j : 64 + tx * 4 + j - 4); if (col < N) epi(row, col, acc[i][j]); } }
}

__device__ __forceinline__ void post_slot(bf16_t* proj, int row, int slot, const float* nq, const float* nk, const float* fq, const float* fk, const float* rope, int lane) {
    int col; const float* g; bool do_rope;
    if (slot < 16) { col = C_NSAQ + slot * 128; g = nq; do_rope = true; }
    else if (slot < 20) { col = C_KS + (slot - 16) * 128; g = nk; do_rope = true; }
    else if (slot < 24) { col = C_KW + (slot - 20) * 128; g = nk; do_rope = true; }
    else if (slot < 40) { col = C_FQ + (slot - 24) * 128; g = fq; do_rope = false; }
    else { col = C_FK + (slot - 40) * 128; g = fk; do_rope = false; }
    unsigned* p = (unsigned*)(proj + (size_t)row * PITCH + col) + lane;
    const unsigned raw = *p;
    float x0 = __uint_as_float(raw << 16), x1 = __uint_as_float(raw & 0xffff0000u);
    const float ss = wave_sum(x0 * x0 + x1 * x1);
    const float rstd = 1.0f / sqrtf(ss * (1.f / 128.f) + RMS_EPS);
    x0 = x0 * rstd * g[2 * lane]; x1 = x1 * rstd * g[2 * lane + 1];
    if (do_rope) {
        const int t = row % SEQ;
        const float y0 = __shfl_xor(x0, 8), y1 = __shfl_xor(x1, 8);
        if (lane < 16) {
            const int i0 = (2 * lane) & 15;
            const float c0 = rope[t * 16 + i0], c1 = rope[t * 16 + i0 + 1], s0 = rope[2048 * 16 + t * 16 + i0], s1 = rope[2048 * 16 + t * 16 + i0 + 1];
            if (lane < 8) { x0 = x0 * c0 - y0 * s0; x1 = x1 * c1 - y1 * s1; }
            else          { x0 = y0 * s0 + x0 * c0; x1 = y1 * s1 + x1 * c1; }
        }
    }
    *p = (unsigned)f2bf(x0) | ((unsigned)f2bf(x1) << 16);
}
__global__ __launch_bounds__(256) void k_post(bf16_t* proj, const float* nq, const float* nk, const float* fq, const float* fk, const float* rope) {
    const int lane = threadIdx.x & 63; const long gw = ((long)blockIdx.x * 256 + threadIdx.x) >> 6, nw = ((long)gridDim.x * 256) >> 6;
    for (long it = gw; it < (long)M * 56; it += nw) post_slot(proj, (int)(it / 56), (int)(it % 56), nq, nk, fq, fk, rope, lane);
}

__device__ __forceinline__ void cumsum_bh(int bh, const float* small, const float* b_forget, float* cum, int lane) {
    const int b = bh >> 4, h = bh & 15; const float bf = b_forget[h];
    float ls[32]; double tot = 0.0;
#pragma unroll
    for (int i = 0; i < 32; ++i) ls[i] = small[((size_t)b * SEQ + lane * 32 + i) * 64 + 48 + h];
    __builtin_amdgcn_sched_barrier(0);
#pragma unroll
    for (int i = 0; i < 32; ++i) { const float x = ls[i] + bf;
        ls[i] = fminf(x, 0.f) - log1pf(expf(-fabsf(x))); tot += (double)ls[i]; }
    double inc = tot;
#pragma unroll
    for (int o = 1; o < 64; o <<= 1) { const double up = __shfl_up(inc, o); if (lane >= o) inc += up; }
    double run = inc - tot;
#pragma unroll
    for (int i = 0; i < 32; ++i) { run += (double)ls[i]; cum[(size_t)bh * SEQ + lane * 32 + i] = (float)run; }
}
__global__ __launch_bounds__(64) void k_cumsum(const float* small, const float* b_forget, float* cum) { cumsum_bh(blockIdx.x, small, b_forget, cum, threadIdx.x); }

__device__ __forceinline__ float gelu_tanh(float x) { const float u = 0.7978845608028654f * (x + 0.044715f * x * x * x); return 0.5f * x * (1.f + tanhf(u)); }
__global__ __launch_bounds__(128) void k_compress(const bf16_t* proj, const float* c1, const float* w1k, const float* w1v, const float* w2k, const float* w2v,
                                                  const float* nk, const float* rope, bf16_t* kcmp, bf16_t* vcmp) {
    __shared__ float xs[4096]; __shared__ float h1[128]; __shared__ float red[2];
    const int j = threadIdx.x; int idx = blockIdx.x;
    const int n = idx & 127; idx >>= 7; const int g = idx & 3; idx >>= 2; const int b = idx & 3; const int which = idx >> 2;
    bf16_t* out = (which ? vcmp : kcmp) + ((size_t)(b * 4 + g) * 128 + n) * 128;
    if (n >= NCMP) { out[j] = 0; return; }
    const int col = (which ? C_VC : C_KC) + g * 128;
    for (int e = j; e < 4096; e += 128) { const int l = e >> 7, d = e & 127; xs[e] = bf2f(proj[((size_t)b * SEQ + 16 * n + l) * PITCH + col + d]); }
    __syncthreads();
    const float* w1 = which ? w1v : w1k; const float* w2 = which ? w2v : w2k;
    float a = c1[which * 128 + j];
#pragma unroll 8
    for (int k = 0; k < 4096; ++k) a += xs[k] * w1[(size_t)k * 128 + j];
    h1[j] = gelu_tanh(a);
    __syncthreads();
    float o = 0.f;
#pragma unroll 8
    for (int i = 0; i < 128; ++i) o += h1[i] * w2[i * 128 + j];
    if (which == 0) {
        float ss = wave_sum(o * o);
        __syncthreads();
        if ((j & 63) == 0) red[j >> 6] = ss;
        __syncthreads();
        ss = red[0] + red[1];
        const float rstd = 1.0f / sqrtf(ss * (1.f / 128.f) + RMS_EPS);
        o = o * rstd * nk[j];
        __syncthreads();
        h1[j] = o;
        __syncthreads();
        if (j < 32) { const int t = 16 * n + 31, i = j & 15; const float c = rope[t * 16 + i], s = rope[2048 * 16 + t * 16 + i];
            const float xa = h1[i], xb = h1[i + 16]; o = (j < 16) ? xa * c - xb * s : xa * s + xb * c; }
    }
    out[j] = f2bf(o);
}


__device__ __forceinline__ void dot_row4(const bf16_t* kr, const float (*q)[128], float& a0, float& a1, float& a2, float& a3) {
#pragma unroll 4
    for (int c = 0; c < 16; ++c) { const u32x4 raw = *(const u32x4*)(kr + c * 8);
#pragma unroll
        for (int e = 0; e < 4; ++e) { const float lo = __uint_as_float(raw[e] << 16), hi = __uint_as_float(raw[e] & 0xffff0000u); const int d = c * 8 + 2 * e;
            a0 += q[0][d] * lo + q[0][d + 1] * hi; a1 += q[1][d] * lo + q[1][d + 1] * hi; a2 += q[2][d] * lo + q[2][d + 1] * hi; a3 += q[3][d] * lo + q[3][d + 1] * hi; } }
}
__device__ __forceinline__ float dot_row1(const bf16_t* kr, const float* q) {
    float a = 0.f;
#pragma unroll 4
    for (int c = 0; c < 16; ++c) { const u32x4 raw = *(const u32x4*)(kr + c * 8);
#pragma unroll
        for (int e = 0; e < 4; ++e) { const float lo = __uint_as_float(raw[e] << 16), hi = __uint_as_float(raw[e] & 0xffff0000u); const int d = c * 8 + 2 * e; a += q[d] * lo + q[d + 1] * hi; } }
    return a;
}

__global__ __launch_bounds__(64) void k_nsa_naive(const bf16_t* proj, const float* small, const bf16_t* kcmp, const bf16_t* vcmp, bf16_t* onsa) {
    __shared__ float qf[4][128]; __shared__ float sc[4][1024]; __shared__ float psum[128]; __shared__ float impS[32]; __shared__ int blk[16];
    const int lane = threadIdx.x; int idx = blockIdx.x;
    const int g = idx & 3; const int t = (idx >> 2) & (SEQ - 1); const int b = idx >> 13;
    const size_t row = (size_t)b * SEQ + t; const float NINF = -__builtin_inff();
    for (int i = lane; i < 512; i += 64) { const int r = i >> 7, d = i & 127; qf[r][d] = bf2f(proj[row * PITCH + C_NSAQ + (g * 4 + r) * 128 + d]); }
    if (lane < 16) blk[lane] = 0;
    __syncthreads();
    float oc[4][2], os[4][2], ow[4][2];
    const bf16_t* kc = kcmp + (size_t)(b * 4 + g) * 128 * 128; const bf16_t* vc = vcmp + (size_t)(b * 4 + g) * 128 * 128;
    {
        float s[4][2];
        for (int h2 = 0; h2 < 2; ++h2) { const int n = lane + 64 * h2; const bool valid = (n < NCMP) && (16 * n + 31 <= t);
            float a0 = 0.f, a1 = 0.f, a2 = 0.f, a3 = 0.f;
            if (valid) dot_row4(kc + n * 128, qf, a0, a1, a2, a3);
            s[0][h2] = valid ? a0 * ATT_SCALE : NINF; s[1][h2] = valid ? a1 * ATT_SCALE : NINF; s[2][h2] = valid ? a2 * ATT_SCALE : NINF; s[3][h2] = valid ? a3 * ATT_SCALE : NINF; }
        float ps0 = 0.f, ps1 = 0.f;
        for (int r = 0; r < 4; ++r) { float m = wave_max(fmaxf(s[r][0], s[r][1])); if (m == NINF) m = 0.f;
            float p0 = __expf(s[r][0] - m), p1 = __expf(s[r][1] - m); float sum = wave_sum(p0 + p1); const float den = sum > 0.f ? sum : 1.f;
            p0 /= den; p1 /= den; sc[r][lane] = p0; sc[r][lane + 64] = p1; ps0 += p0; ps1 += p1; }
        psum[lane] = ps0; psum[lane + 64] = ps1;
    }
    __syncthreads();
    for (int r = 0; r < 4; ++r) for (int dd = 0; dd < 2; ++dd) { const int d = lane + 64 * dd; float a = 0.f;
        for (int n = 0; n < NCMP; ++n) { const float p = sc[r][n]; if (p != 0.f) a += p * bf2f(vc[n * 128 + d]); } oc[r][dd] = a; }
    const int cur = t >> 6;
    if (lane < 32) { const int j = lane; float im = 0.f;
        for (int i = 4 * j - 1; i <= 4 * j + 3; ++i) if (i >= 0 && i < NCMP) im += psum[i];
        const bool forced = (j == 0) || (j == cur) || (j == cur - 1); const bool causal = j <= cur;
        impS[j] = forced ? __builtin_inff() : (causal ? im : NINF); }
    __syncthreads();
    bool selj = false;
    if (lane < 32) { const float sj = impS[lane]; int rank = 0;
        for (int k = 0; k < 32; ++k) { const float sk = impS[k]; if (sk > sj || (sk == sj && k < lane)) ++rank; }
        selj = (rank < 16) && (sj > NINF); }
    const unsigned selmask = (unsigned)__ballot(selj);
    __syncthreads();
    {
        int nsel = 0;
        for (int j = 0; j < 32; ++j) if ((selmask >> j) & 1u) { const int key = 64 * j + lane; const bool valid = key <= t;
            float a0 = 0.f, a1 = 0.f, a2 = 0.f, a3 = 0.f;
            if (valid) { const bf16_t* kr = proj + ((size_t)b * SEQ + key) * PITCH + C_KS + g * 128;
                dot_row4(kr, qf, a0, a1, a2, a3); }
            sc[0][nsel * 64 + lane] = valid ? a0 * ATT_SCALE : NINF; sc[1][nsel * 64 + lane] = valid ? a1 * ATT_SCALE : NINF;
            sc[2][nsel * 64 + lane] = valid ? a2 * ATT_SCALE : NINF; sc[3][nsel * 64 + lane] = valid ? a3 * ATT_SCALE : NINF;
            if (lane == 0) blk[nsel] = j; ++nsel; }
        __syncthreads();
        for (int r = 0; r < 4; ++r) { float m = NINF; for (int i = lane; i < nsel * 64; i += 64) m = fmaxf(m, sc[r][i]); m = wave_max(m); if (m == NINF) m = 0.f;
            float sum = 0.f; for (int i = lane; i < nsel * 64; i += 64) { const float p = __expf(sc[r][i] - m); sc[r][i] = p; sum += p; } sum = wave_sum(sum);
            const float den = sum > 0.f ? sum : 1.f; for (int i = lane; i < nsel * 64; i += 64) sc[r][i] /= den; }
        __syncthreads();
        for (int r = 0; r < 4; ++r) for (int dd = 0; dd < 2; ++dd) os[r][dd] = 0.f;
        for (int si = 0; si < nsel; ++si) { const int j = blk[si];
            for (int kk = 0; kk < 64; ++kk) { const int key = 64 * j + kk; if (key > t) break;
                const bf16_t* vr = proj + ((size_t)b * SEQ + key) * PITCH + C_VS + g * 128; const float v0 = bf2f(vr[lane]), v1 = bf2f(vr[lane + 64]);
                for (int r = 0; r < 4; ++r) { const float p = sc[r][si * 64 + kk]; os[r][0] += p * v0; os[r][1] += p * v1; } } }
    }
    __syncthreads();
    {
        const int klo = t - 511 > 0 ? t - 511 : 0; const int nk = t - klo + 1;
        for (int i = lane; i < 512; i += 64) { const bool valid = i < nk; float a0 = 0.f, a1 = 0.f, a2 = 0.f, a3 = 0.f;
            if (valid) { const bf16_t* kr = proj + ((size_t)b * SEQ + klo + i) * PITCH + C_KW + g * 128;
                dot_row4(kr, qf, a0, a1, a2, a3); }
            sc[0][i] = valid ? a0 * ATT_SCALE : NINF; sc[1][i] = valid ? a1 * ATT_SCALE : NINF; sc[2][i] = valid ? a2 * ATT_SCALE : NINF; sc[3][i] = valid ? a3 * ATT_SCALE : NINF; }
        __syncthreads();
        for (int r = 0; r < 4; ++r) { float m = NINF; for (int i = lane; i < 512; i += 64) m = fmaxf(m, sc[r][i]); m = wave_max(m); if (m == NINF) m = 0.f;
            float sum = 0.f; for (int i = lane; i < 512; i += 64) { const float p = __expf(sc[r][i] - m); sc[r][i] = p; sum += p; } sum = wave_sum(sum);
            const float den = sum > 0.f ? sum : 1.f; for (int i = lane; i < 512; i += 64) sc[r][i] /= den; }
        __syncthreads();
        for (int r = 0; r < 4; ++r) for (int dd = 0; dd < 2; ++dd) ow[r][dd] = 0.f;
        for (int i = 0; i < nk; ++i) { const bf16_t* vr = proj + ((size_t)b * SEQ + klo + i) * PITCH + C_VW + g * 128; const float v0 = bf2f(vr[lane]), v1 = bf2f(vr[lane + 64]);
            for (int r = 0; r < 4; ++r) { const float p = sc[r][i]; ow[r][0] += p * v0; ow[r][1] += p * v1; } }
    }
    for (int r = 0; r < 4; ++r) { const int head = g * 4 + r; const float* gl = small + row * 64 + head * 3;
        const float g0 = sigmoidf_(gl[0]), g1 = sigmoidf_(gl[1]), g2 = sigmoidf_(gl[2]);
        for (int dd = 0; dd < 2; ++dd) onsa[row * 2048 + head * 128 + lane + 64 * dd] = f2bf(g0 * oc[r][dd] + g1 * os[r][dd] + g2 * ow[r][dd]); }
}

__global__ __launch_bounds__(64) void k_fox_naive(const bf16_t* proj, const float* cum, bf16_t* ofox) {
    __shared__ float qf[128]; __shared__ float sc[2048];
    const int lane = threadIdx.x; int idx = blockIdx.x;
    const int h = idx & 15; const int t = (idx >> 4) & (SEQ - 1); const int b = idx >> 15;
    const size_t row = (size_t)b * SEQ + t;
    qf[lane] = bf2f(proj[row * PITCH + C_FQ + h * 128 + lane]); qf[lane + 64] = bf2f(proj[row * PITCH + C_FQ + h * 128 + lane + 64]);
    __syncthreads();
    const float* cm = cum + (size_t)(b * 16 + h) * SEQ; const float ct = cm[t];
    float m = -__builtin_inff();
    for (int s = lane; s <= t; s += 64) { const bf16_t* kr = proj + ((size_t)b * SEQ + s) * PITCH + C_FK + h * 128; float a = dot_row1(kr, qf);
        a = a * ATT_SCALE + (ct - cm[s]); sc[s] = a; m = fmaxf(m, a); }
    m = wave_max(m);
    float sum = 0.f;
    for (int s = lane; s <= t; s += 64) { const float p = __expf(sc[s] - m); sc[s] = p; sum += p; }
    sum = wave_sum(sum);
    __syncthreads();
    float o0 = 0.f, o1 = 0.f;
    for (int s = 0; s <= t; ++s) { const bf16_t* vr = proj + ((size_t)b * SEQ + s) * PITCH + C_FV + h * 128; const float p = sc[s]; o0 += p * bf2f(vr[lane]); o1 += p * bf2f(vr[lane + 64]); }
    ofox[row * 2048 + h * 128 + lane] = f2bf(o0 / sum); ofox[row * 2048 + h * 128 + lane + 64] = f2bf(o1 / sum);
}


namespace pg8 {
#define PG8_LAS __attribute__((address_space(3)))
typedef unsigned short bf16_t;
typedef short bf16x8 __attribute__((ext_vector_type(8)));
typedef float f32x4 __attribute__((ext_vector_type(4)));
typedef unsigned u32x4 __attribute__((ext_vector_type(4)));
constexpr int BM = 256, BK = 64, HALF = 128, HTB = HALF * BK * 2  , STAGE_BYTES = 8 * HTB, NXCD = 8, WGM = 8;

__host__ __device__ __forceinline__ int lds_byte(int r, int c) { const int st = (r >> 4) * 2 + (c >> 5), rr = r & 15, cc = c & 31, ob = rr * 64 + cc * 2; return st * 1024 + (ob ^ (((ob >> 9) & 1) << 5)); }
__host__ __device__ __forceinline__ void stage_rc(int b, int& R, int& C) { const int st = b / 1024, sb = b % 1024, swz = sb ^ (((sb >> 9) & 1) << 5); R = (st >> 1) * 16 + swz / 64; C = (st & 1) * 32 + (swz % 64) / 2; }
__host__ __device__ __forceinline__ int perm32(int rho) { const int n = rho >> 4, i = rho & 15; return 8 * (i >> 2) + 4 * n + (i & 3); }

struct Unit { int pm, pn; };
struct Gemm { const bf16_t* A; const bf16_t* Bt; int M, N, K; };

struct StaticOrder {
    int nM, nN, nwg, G, c;
    __host__ __device__ void init(int M, int N, int G_, int c_) { nM = M / BM; nN = N / BM; nwg = nM * nN; G = G_; c = c_; }
    __host__ __device__ bool next(int i, Unit& u) const {
        const long L = (long)i * G + c; if (L >= nwg) return false;
        int wgid = (int)L; { const int q = nwg / NXCD, r = nwg % NXCD, xcd = wgid % NXCD, off = wgid / NXCD; wgid = (xcd < r ? xcd * (q + 1) : r * (q + 1) + (xcd - r) * q) + off; }
        const int nig = WGM * nN, gid = wgid / nig, fm = gid * WGM, gsz = (nM - fm) < WGM ? (nM - fm) : WGM;
        u.pm = fm + ((wgid % nig) % gsz); u.pn = (wgid % nig) / gsz; return true;
    }
    __device__ __forceinline__ void a_ready(const Unit&) const {}
    __device__ __forceinline__ void done(const Unit&) const {}
};

__device__ __forceinline__ unsigned cvt_pk_bf16(float lo, float hi) { unsigned r; asm("v_cvt_pk_bf16_f32 %0, %1, %2" : "=v"(r) : "v"(lo), "v"(hi)); return r; }
typedef float f32x2 __attribute__((ext_vector_type(2)));

template <class Epi, class Sched, bool ALIGN_EPI = false, bool SP2 = false>
__device__ __forceinline__ void gemm_phase(PG8_LAS unsigned char* lds, const Gemm g, const Sched& S, const Epi& E, const int tid) {
    const int wid = __builtin_amdgcn_readfirstlane(tid >> 6), lane = tid & 63, wr = wid >> 2, wc = wid & 3, fr = lane & 15, fq = lane >> 4;
    const int K = g.K, nt = K / BK;
    unsigned voffA[2], voffB[2];
#pragma unroll
    for (int i = 0; i < 2; ++i) { int R, C; stage_rc(tid * 16 + i * 8192, R, C); const int Rb = Epi::PERM ? ((R & ~31) + perm32(R & 31)) : R;
        voffA[i] = (unsigned)(R * K + C) * 2u; voffB[i] = (unsigned)(Rb * K + C) * 2u; }
    const size_t kstep = (size_t)(BK * 2);
    const size_t hstep = (size_t)HALF * K * 2;
    const size_t tstep = 2 * hstep;
    const unsigned ldsw = (unsigned)wid * 1024u;
    const int aoff = lds_byte(wr * 64 + fr, fq * 8), boff = lds_byte(wc * 32 + fr, fq * 8);
#define PG8_SA(b, h) (((b) * 2 + (h)) * HTB)
#define PG8_SB(b, h) ((4 + (b) * 2 + (h)) * HTB)
#define PG8_STAGE(bufoff, gbase, voff) do { _Pragma("unroll") for (int _i = 0; _i < 2; ++_i) \
        __builtin_amdgcn_global_load_lds((const unsigned*)((const char*)(gbase) + (voff)[_i]), (PG8_LAS unsigned*)(lds + (bufoff) + ldsw + _i * 8192), 16, 0, 0); } while (0)
#define PG8_LDA(dst, b, h) do { _Pragma("unroll") for (int m = 0; m < 4; ++m) _Pragma("unroll") for (int k = 0; k < 2; ++k) dst[m][k] = *(const PG8_LAS bf16x8*)(lds + PG8_SA(b, h) + aoff + m * 2048 + k * 1024); } while (0)
#define PG8_LDB(dst, b, h) do { _Pragma("unroll") for (int n = 0; n < 2; ++n) _Pragma("unroll") for (int k = 0; k < 2; ++k) dst[n][k] = *(const PG8_LAS bf16x8*)(lds + PG8_SB(b, h) + boff + n * 2048 + k * 1024); } while (0)
#define PG8_MMA(ai, bj, At, Bt) do { __builtin_amdgcn_s_setprio(1); _Pragma("unroll") for (int m = 0; m < 4; ++m) _Pragma("unroll") for (int n = 0; n < 2; ++n) _Pragma("unroll") for (int k = 0; k < 2; ++k) \
        acc[ai][bj][m][n] = __builtin_amdgcn_mfma_f32_16x16x32_bf16(Bt[n][k], At[m][k], acc[ai][bj][m][n], 0, 0, 0); __builtin_amdgcn_s_setprio(0); } while (0)
#define PG8_WAIT_V(n) asm volatile("s_waitcnt vmcnt(" #n ")" ::: "memory")
#define PG8_WAIT_L(n) asm volatile("s_waitcnt lgkmcnt(" #n ")" ::: "memory")
#define PG8_BAR __builtin_amdgcn_s_barrier()
#define PG8_SCHED __builtin_amdgcn_sched_barrier(0)
    Unit cur, nxt; int ui = 0;
    if (!S.next(0, cur)) return;
    f32x4 acc[2][2][4][2];
#pragma unroll
    for (int a = 0; a < 2; ++a)
#pragma unroll
        for (int b = 0; b < 2; ++b)
#pragma unroll
            for (int m = 0; m < 4; ++m)
#pragma unroll
                for (int n = 0; n < 2; ++n) acc[a][b][m][n] = (f32x4){0.f, 0.f, 0.f, 0.f};
    bf16x8 At[4][2], B0[2][2], B1[2][2];
    const char* cA = (const char*)g.A + (size_t)cur.pm * tstep; const char* cB = (const char*)g.Bt + (size_t)cur.pn * tstep;
    S.a_ready(cur);
    if constexpr (SP2) {
        PG8_STAGE(PG8_SB(0, 0), cB, voffB); PG8_STAGE(PG8_SB(0, 1), cB + hstep, voffB); PG8_STAGE(PG8_SA(0, 0), cA, voffA); PG8_STAGE(PG8_SA(0, 1), cA + hstep, voffA);
        if (wr == 1) PG8_BAR;
        PG8_WAIT_V(2); PG8_BAR;
        PG8_STAGE(PG8_SB(1, 0), cB + kstep, voffB); PG8_STAGE(PG8_SA(1, 0), cA + kstep, voffA); PG8_STAGE(PG8_SB(1, 1), cB + hstep + kstep, voffB);
        PG8_WAIT_V(6); PG8_BAR;
    } else {
        PG8_STAGE(PG8_SB(0, 0), cB, voffB); PG8_STAGE(PG8_SA(0, 0), cA, voffA); PG8_STAGE(PG8_SB(0, 1), cB + hstep, voffB); PG8_STAGE(PG8_SA(0, 1), cA + hstep, voffA);
        if (wr == 1) PG8_BAR;
        PG8_WAIT_V(4); PG8_BAR;
        PG8_STAGE(PG8_SB(1, 0), cB + kstep, voffB); PG8_STAGE(PG8_SA(1, 0), cA + kstep, voffA); PG8_STAGE(PG8_SB(1, 1), cB + hstep + kstep, voffB);
        PG8_WAIT_V(6); PG8_BAR;
    }
    for (;;) {
        const bool has_next = S.next(ui + 1, nxt);
        const char* nA = has_next ? (const char*)g.A + (size_t)nxt.pm * tstep : cA; const char* nB = has_next ? (const char*)g.Bt + (size_t)nxt.pn * tstep : cB;
        for (int t = 0; t < nt; t += 2) {
            const bool last = (t == nt - 2);
            const char* a1 = cA + (size_t)(t + 1) * kstep;
            const char* a2 = last ? nA : cA + (size_t)(t + 2) * kstep; const char* b2 = last ? nB : cB + (size_t)(t + 2) * kstep;
            const char* a3 = a2 + kstep; const char* b3 = b2 + kstep;
            if (last && has_next) S.a_ready(nxt);
            if constexpr (Epi::HAS_PRE) { if (last) E.pre(cur, wr, wc, fr, fq); }
            if constexpr (SP2) {
            PG8_LDB(B0, 0, 0); PG8_LDB(B1, 0, 1); PG8_SCHED; PG8_LDA(At, 0, 0); PG8_STAGE(PG8_SA(1, 1), a1 + hstep, voffA);
            PG8_WAIT_V(8); PG8_WAIT_L(0); PG8_BAR; PG8_MMA(0, 0, At, B0); PG8_MMA(0, 1, At, B1); PG8_BAR; PG8_SCHED;
            PG8_LDA(At, 0, 1); PG8_STAGE(PG8_SB(0, 0), b2, voffB); PG8_STAGE(PG8_SB(0, 1), b2 + hstep, voffB); PG8_STAGE(PG8_SA(0, 0), a2, voffA);
            PG8_WAIT_V(8); PG8_WAIT_L(0); PG8_BAR; PG8_MMA(1, 0, At, B0); PG8_MMA(1, 1, At, B1); PG8_BAR; PG8_SCHED;
            PG8_LDB(B0, 1, 0); PG8_LDB(B1, 1, 1); PG8_SCHED; PG8_LDA(At, 1, 0); PG8_STAGE(PG8_SA(0, 1), a2 + hstep, voffA);
            PG8_WAIT_V(8); PG8_WAIT_L(0); PG8_BAR; PG8_MMA(0, 0, At, B0); PG8_MMA(0, 1, At, B1); PG8_BAR; PG8_SCHED;
            PG8_LDA(At, 1, 1); PG8_STAGE(PG8_SB(1, 0), b3, voffB); PG8_STAGE(PG8_SB(1, 1), b3 + hstep, voffB); PG8_STAGE(PG8_SA(1, 0), a3, voffA);
            PG8_WAIT_V(8); PG8_WAIT_L(0); PG8_BAR; PG8_MMA(1, 0, At, B0); PG8_MMA(1, 1, At, B1); PG8_BAR; PG8_SCHED;
            } else {
            PG8_LDB(B0, 0, 0); PG8_SCHED; PG8_LDA(At, 0, 0); PG8_STAGE(PG8_SA(1, 1), a1 + hstep, voffA);
            PG8_WAIT_L(8); PG8_BAR; PG8_WAIT_L(0); PG8_MMA(0, 0, At, B0); PG8_BAR; PG8_SCHED;
            PG8_LDB(B1, 0, 1); PG8_STAGE(PG8_SB(0, 0), b2, voffB);
            PG8_BAR; PG8_WAIT_L(0); PG8_MMA(0, 1, At, B1); PG8_BAR;
            PG8_LDA(At, 0, 1); PG8_STAGE(PG8_SA(0, 0), a2, voffA);
            PG8_BAR; PG8_WAIT_L(0); PG8_MMA(1, 0, At, B0); PG8_BAR; PG8_SCHED;
            PG8_STAGE(PG8_SB(0, 1), b2 + hstep, voffB);
            PG8_WAIT_V(6); PG8_BAR; PG8_MMA(1, 1, At, B1); PG8_BAR;
            PG8_LDB(B0, 1, 0); PG8_SCHED; PG8_LDA(At, 1, 0); PG8_STAGE(PG8_SA(0, 1), a2 + hstep, voffA);
            PG8_WAIT_L(8); PG8_BAR; PG8_WAIT_L(0); PG8_MMA(0, 0, At, B0); PG8_BAR; PG8_SCHED;
            PG8_LDB(B1, 1, 1); PG8_STAGE(PG8_SB(1, 0), b3, voffB);
            PG8_BAR; PG8_WAIT_L(0); PG8_MMA(0, 1, At, B1); PG8_BAR;
            PG8_LDA(At, 1, 1); PG8_STAGE(PG8_SA(1, 0), a3, voffA);
            PG8_BAR; PG8_WAIT_L(0); PG8_MMA(1, 0, At, B0); PG8_BAR; PG8_SCHED;
            PG8_STAGE(PG8_SB(1, 1), b3 + hstep, voffB);
            PG8_WAIT_V(6); PG8_BAR; PG8_MMA(1, 1, At, B1); PG8_BAR;
            }
        }
        if constexpr (ALIGN_EPI) { if (wr == 0) PG8_BAR; }
        if constexpr (!Epi::AFTER_DRAIN) { E(acc, cur, wr, wc, fr, fq); S.done(cur); }
        if (!has_next) break;
#pragma unroll
        for (int a = 0; a < 2; ++a)
#pragma unroll
            for (int b = 0; b < 2; ++b)
#pragma unroll
                for (int m = 0; m < 4; ++m)
#pragma unroll
                    for (int n = 0; n < 2; ++n) acc[a][b][m][n] = (f32x4){0.f, 0.f, 0.f, 0.f};
        cur = nxt; cA = nA; cB = nB; ++ui;
        if constexpr (ALIGN_EPI) { if (wr == 1) PG8_BAR; }
    }
    PG8_WAIT_V(0);
    if constexpr (!ALIGN_EPI) { if (wr == 0) PG8_BAR; }
    PG8_BAR;
    if constexpr (Epi::AFTER_DRAIN) { E.fused(acc, cur, wr, wc, fr, fq, lds, wid, lane); S.done(cur); }
#undef PG8_SA
#undef PG8_SB
#undef PG8_STAGE
#undef PG8_LDA
#undef PG8_LDB
#undef PG8_MMA
#undef PG8_WAIT_V
#undef PG8_WAIT_L
#undef PG8_BAR
#undef PG8_SCHED
}
}


namespace pg8 {
__device__ __forceinline__ float sigm(float x) { return __builtin_amdgcn_rcpf(1.f + __expf(-x));     }
__device__ __forceinline__ void unpack8(const u32x4 w, float (&f)[8]) {
#pragma unroll
    for (int e = 0; e < 4; ++e) { f[2 * e] = __uint_as_float(w[e] << 16); f[2 * e + 1] = __uint_as_float(w[e] & 0xffff0000u); }
}
struct EpiProjF { static constexpr bool PERM = true, AFTER_DRAIN = false, HAS_PRE = false; bf16_t* proj; float* small;
    __device__ __forceinline__ void operator()(const f32x4 (&acc)[2][2][4][2], const Unit& u, int wr, int wc, int fr, int fq) const {
        const int row0 = u.pm * BM + wr * 64 + fr;
        if (u.pn < 76) {
            const int col0 = u.pn * BM + wc * 32 + 8 * fq;
#pragma unroll
            for (int ai = 0; ai < 2; ++ai)
#pragma unroll
                for (int m = 0; m < 4; ++m) { bf16_t* rowp = proj + (size_t)(row0 + ai * HALF + m * 16) * PITCH + col0;
#pragma unroll
                    for (int bj = 0; bj < 2; ++bj) { const f32x4 v0 = acc[ai][bj][m][0], v1 = acc[ai][bj][m][1];
                        u32x4 w; w.x = cvt_pk_bf16(v0[0], v0[1]); w.y = cvt_pk_bf16(v0[2], v0[3]); w.z = cvt_pk_bf16(v1[0], v1[1]); w.w = cvt_pk_bf16(v1[2], v1[3]);
                        *(u32x4*)(rowp + bj * HALF) = w; } }
        } else if (wc < 2) {
#pragma unroll
            for (int ai = 0; ai < 2; ++ai)
#pragma unroll
                for (int m = 0; m < 4; ++m) { float* rp = small + (size_t)(row0 + ai * HALF + m * 16) * 64 + wc * 32 + 8 * fq;
                    *(f32x4*)rp = acc[ai][0][m][0]; *(f32x4*)(rp + 4) = acc[ai][0][m][1]; }
        }
    }
};
template <bool UPB> struct EpiUpF { static constexpr bool PERM = true, AFTER_DRAIN = false, HAS_PRE = false; const bf16_t* proj; bf16_t* y;
    __device__ __forceinline__ void operator()(const f32x4 (&acc)[2][2][4][2], const Unit& u, int wr, int wc, int fr, int fq) const {
        const int row0 = u.pm * BM + wr * 64 + fr; const int col0 = u.pn * BM + wc * 32 + 8 * fq;
#pragma unroll
        for (int ai = 0; ai < 2; ++ai)
#pragma unroll
            for (int m = 0; m < 4; ++m) { const size_t row = (size_t)(row0 + ai * HALF + m * 16);
#pragma unroll
                for (int bj = 0; bj < 2; ++bj) { const int col = col0 + bj * HALF;
                    const u32x4 gw = *(const u32x4*)(proj + row * PITCH + (UPB ? C_GB : C_GA) + col); float g[8]; unpack8(gw, g);
                    const f32x4 v0 = acc[ai][bj][m][0], v1 = acc[ai][bj][m][1];
                    float o[8] = {v0[0], v0[1], v0[2], v0[3], v1[0], v1[1], v1[2], v1[3]};
#pragma unroll
                    for (int e = 0; e < 8; ++e) o[e] *= sigm(g[e]);
                    if (UPB) { const u32x4 yw = *(const u32x4*)(y + row * DM + col); float yo[8]; unpack8(yw, yo);
#pragma unroll
                        for (int e = 0; e < 8; ++e) o[e] += yo[e]; }
                    u32x4 w; w.x = cvt_pk_bf16(o[0], o[1]); w.y = cvt_pk_bf16(o[2], o[3]); w.z = cvt_pk_bf16(o[4], o[5]); w.w = cvt_pk_bf16(o[6], o[7]);
                    *(u32x4*)(y + row * DM + col) = w; } }
    }
};
struct UpOrder { StaticOrder base;
    __device__ __forceinline__ bool next(int i, Unit& u) const { Unit t; if (!base.next(i >> 1, t)) return false; u.pm = t.pm + (i & 1) * (M / BM); u.pn = t.pn + (i & 1) * (DM / BM); return true; }
    __device__ __forceinline__ void a_ready(const Unit&) const {}
    __device__ __forceinline__ void done(const Unit&) const {}
};
struct EpiUpCat { static constexpr bool PERM = true, AFTER_DRAIN = false, HAS_PRE = false; const bf16_t* proj; bf16_t* y;
    __device__ __forceinline__ void operator()(const f32x4 (&acc)[2][2][4][2], const Unit& u, int wr, int wc, int fr, int fq) const {
        const bool upb = u.pm >= M / BM; const int pm = upb ? u.pm - M / BM : u.pm, pn = upb ? u.pn - DM / BM : u.pn;
        const int row0 = pm * BM + wr * 64 + fr; const int col0 = pn * BM + wc * 32 + 8 * fq; const int gcol = upb ? C_GB : C_GA;
#pragma unroll
        for (int ai = 0; ai < 2; ++ai) {
            u32x4 gw[4][2], yw[4][2];
#pragma unroll
            for (int m = 0; m < 4; ++m)
#pragma unroll
                for (int bj = 0; bj < 2; ++bj) gw[m][bj] = *(const u32x4*)(proj + (size_t)(row0 + ai * HALF + m * 16) * PITCH + gcol + col0 + bj * HALF);
            if (upb) {
#pragma unroll
                for (int m = 0; m < 4; ++m)
#pragma unroll
                    for (int bj = 0; bj < 2; ++bj) yw[m][bj] = *(const u32x4*)(y + (size_t)(row0 + ai * HALF + m * 16) * DM + col0 + bj * HALF);
            }
#pragma unroll
            for (int m = 0; m < 4; ++m) { const size_t row = (size_t)(row0 + ai * HALF + m * 16);
#pragma unroll
                for (int bj = 0; bj < 2; ++bj) { const int col = col0 + bj * HALF;
                    float g[8]; unpack8(gw[m][bj], g);
                    const f32x4 v0 = acc[ai][bj][m][0], v1 = acc[ai][bj][m][1];
                    float o[8] = {v0[0], v0[1], v0[2], v0[3], v1[0], v1[1], v1[2], v1[3]};
#pragma unroll
                    for (int e = 0; e < 8; ++e) o[e] *= sigm(g[e]);
                    if (upb) { float yo[8]; unpack8(yw[m][bj], yo);
#pragma unroll
                        for (int e = 0; e < 8; ++e) o[e] += yo[e]; }
                    u32x4 w; w.x = cvt_pk_bf16(o[0], o[1]); w.y = cvt_pk_bf16(o[2], o[3]); w.z = cvt_pk_bf16(o[4], o[5]); w.w = cvt_pk_bf16(o[6], o[7]);
                    *(u32x4*)(y + row * DM + col) = w; } }
        }
    }
};
struct EpiResF { static constexpr bool PERM = false, AFTER_DRAIN = false, HAS_PRE = false; const float* base; const float* gate  ; float* out;
    __device__ __forceinline__ void operator()(const f32x4 (&acc)[2][2][4][2], const Unit& u, int wr, int wc, int fr, int fq) const {
        const int row0 = u.pm * BM + wr * 64 + fr; const int col0 = u.pn * BM + wc * 32 + 4 * fq;
        const float* gb = gate + (size_t)((u.pm * BM) / SEQ) * 24576;
        f32x4 gv[2][2];
#pragma unroll
        for (int bj = 0; bj < 2; ++bj)
#pragma unroll
            for (int n = 0; n < 2; ++n) gv[bj][n] = *(const f32x4*)(gb + col0 + bj * HALF + n * 16);
#pragma unroll
        for (int ai = 0; ai < 2; ++ai) {
            f32x4 bs[4][2][2];
#pragma unroll
            for (int m = 0; m < 4; ++m)
#pragma unroll
                for (int bj = 0; bj < 2; ++bj)
#pragma unroll
                    for (int n = 0; n < 2; ++n) bs[m][bj][n] = *(const f32x4*)(base + (size_t)(row0 + ai * HALF + m * 16) * DM + col0 + bj * HALF + n * 16);
#pragma unroll
            for (int m = 0; m < 4; ++m) { const size_t off = (size_t)(row0 + ai * HALF + m * 16) * DM + col0;
#pragma unroll
                for (int bj = 0; bj < 2; ++bj)
#pragma unroll
                    for (int n = 0; n < 2; ++n) *(f32x4*)(out + off + bj * HALF + n * 16) = bs[m][bj][n] + gv[bj][n] * acc[ai][bj][m][n]; }
        }
    }
};
struct EpiResNormF { static constexpr bool PERM = true, AFTER_DRAIN = false, HAS_PRE = false; const float* base; const float* gate; float* out; const float* g2; const float* scale2  ; bf16_t* an; float* ss;
    __device__ __forceinline__ void operator()(const f32x4 (&acc)[2][2][4][2], const Unit& u, int wr, int wc, int fr, int fq) const {
        const int row0 = u.pm * BM + wr * 64 + fr; const int col0 = u.pn * BM + wc * 32 + 8 * fq;
        const size_t boff = (size_t)((u.pm * BM) / SEQ) * 24576;
        f32x4 gv[2][2], gs[2][2];
#pragma unroll
        for (int bj = 0; bj < 2; ++bj)
#pragma unroll
            for (int n = 0; n < 2; ++n) { const int c = col0 + bj * HALF + n * 4; gv[bj][n] = *(const f32x4*)(gate + boff + c);
                const f32x4 g = *(const f32x4*)(g2 + c), sc = *(const f32x4*)(scale2 + boff + c); gs[bj][n] = g + g * sc; }
#pragma unroll
        for (int ai = 0; ai < 2; ++ai)
#pragma unroll
          for (int mh = 0; mh < 4; mh += 2) {
            f32x4 bsv[2][2][2];
#pragma unroll
            for (int mm = 0; mm < 2; ++mm)
#pragma unroll
                for (int bj = 0; bj < 2; ++bj)
#pragma unroll
                    for (int n = 0; n < 2; ++n) bsv[mm][bj][n] = *(const f32x4*)(base + (size_t)(row0 + ai * HALF + (mh + mm) * 16) * DM + col0 + bj * HALF + n * 4);
#pragma unroll
            for (int mm = 0; mm < 2; ++mm) { const int m = mh + mm; const int row = row0 + ai * HALF + m * 16; const size_t off = (size_t)row * DM + col0; float rs = 0.f;
#pragma unroll
                for (int bj = 0; bj < 2; ++bj) { u32x4 w;
#pragma unroll
                    for (int n = 0; n < 2; ++n) { const f32x4 bs = bsv[mm][bj][n];
                        const f32x4 o = bs + gv[bj][n] * acc[ai][bj][m][n];
                        *(f32x4*)(out + off + bj * HALF + n * 4) = o;
                        rs += (o[0] * o[0] + o[1] * o[1]) + (o[2] * o[2] + o[3] * o[3]);
                        const f32x4 a = o * gs[bj][n];
                        if (n == 0) { w.x = cvt_pk_bf16(a[0], a[1]); w.y = cvt_pk_bf16(a[2], a[3]); } else { w.z = cvt_pk_bf16(a[0], a[1]); w.w = cvt_pk_bf16(a[2], a[3]); } }
                    *(u32x4*)(an + off + bj * HALF) = w; }
                rs += __shfl_xor(rs, 16); rs += __shfl_xor(rs, 32);
                if (fq == 0) atomicAdd(ss + row, rs); }
          }
    }
};
struct EpiFF1NF { static constexpr bool PERM = true, AFTER_DRAIN = false, HAS_PRE = true; bf16_t* a; const float* ss; const float* cb  ;
    mutable float pss[2][4]; mutable f32x4 pcv[2][2];
    __device__ __forceinline__ void pre(const Unit& u, int wr, int wc, int fr, int fq) const {
        const int row0 = u.pm * BM + wr * 64 + fr; const int col0 = u.pn * BM + wc * 32 + 8 * fq;
        const float* cbb = cb + (size_t)((u.pm * BM) / SEQ) * DFF + col0;
        const float* sp = ss + row0;
#define PRE_LD1(dst, off) asm volatile("global_load_dword %0, %1, off offset:" #off : "=v"(dst) : "v"(sp) : "memory")
        PRE_LD1(pss[0][0], 0); PRE_LD1(pss[0][1], 64); PRE_LD1(pss[0][2], 128); PRE_LD1(pss[0][3], 192);
        PRE_LD1(pss[1][0], 512); PRE_LD1(pss[1][1], 576); PRE_LD1(pss[1][2], 640); PRE_LD1(pss[1][3], 704);
#undef PRE_LD1
#define PRE_LD4(dst, off) asm volatile("global_load_dwordx4 %0, %1, off offset:" #off : "=v"(dst) : "v"(cbb) : "memory")
        PRE_LD4(pcv[0][0], 0); PRE_LD4(pcv[0][1], 16); PRE_LD4(pcv[1][0], 512); PRE_LD4(pcv[1][1], 528);
#undef PRE_LD4
    }
    __device__ __forceinline__ void operator()(const f32x4 (&acc)[2][2][4][2], const Unit& u, int wr, int wc, int fr, int fq) const {
        const int row0 = u.pm * BM + wr * 64 + fr; const int col0 = u.pn * BM + wc * 32 + 8 * fq;
#pragma unroll
        for (int ai = 0; ai < 2; ++ai)
#pragma unroll
            for (int m = 0; m < 4; ++m) { bf16_t* rowp = a + (size_t)(row0 + ai * HALF + m * 16) * DFF + col0;
                const float rd = __builtin_amdgcn_rsqf(pss[ai][m] * (1.f / DM) + RMS_EPS);
#pragma unroll
                for (int bj = 0; bj < 2; ++bj) { f32x4 v0 = acc[ai][bj][m][0] * rd + pcv[bj][0], v1 = acc[ai][bj][m][1] * rd + pcv[bj][1];
                    f32x4 r0, r1;
#pragma unroll
                    for (int e = 0; e < 4; ++e) { asm("v_max_f32 %0, 0, %1" : "=v"(r0[e]) : "v"(v0[e])); asm("v_max_f32 %0, 0, %1" : "=v"(r1[e]) : "v"(v1[e])); }
                    v0 = v0 * r0; v1 = v1 * r1;
                    u32x4 w; w.x = cvt_pk_bf16(v0[0], v0[1]); w.y = cvt_pk_bf16(v0[2], v0[3]); w.z = cvt_pk_bf16(v1[0], v1[1]); w.w = cvt_pk_bf16(v1[2], v1[3]);
                    *(u32x4*)(rowp + bj * HALF) = w; } }
    }
};
struct EpiFF1F { static constexpr bool PERM = true, AFTER_DRAIN = false, HAS_PRE = false; bf16_t* a;
    __device__ __forceinline__ void operator()(const f32x4 (&acc)[2][2][4][2], const Unit& u, int wr, int wc, int fr, int fq) const {
        const int row0 = u.pm * BM + wr * 64 + fr; const int col0 = u.pn * BM + wc * 32 + 8 * fq;
#pragma unroll
        for (int ai = 0; ai < 2; ++ai)
#pragma unroll
            for (int m = 0; m < 4; ++m) { bf16_t* rowp = a + (size_t)(row0 + ai * HALF + m * 16) * DFF + col0;
#pragma unroll
                for (int bj = 0; bj < 2; ++bj) { f32x4 v0 = acc[ai][bj][m][0], v1 = acc[ai][bj][m][1];
                    f32x4 r0, r1;
#pragma unroll
                    for (int e = 0; e < 4; ++e) { asm("v_max_f32 %0, 0, %1" : "=v"(r0[e]) : "v"(v0[e])); asm("v_max_f32 %0, 0, %1" : "=v"(r1[e]) : "v"(v1[e])); }
                    v0 = v0 * r0; v1 = v1 * r1;
                    u32x4 w; w.x = cvt_pk_bf16(v0[0], v0[1]); w.y = cvt_pk_bf16(v0[2], v0[3]); w.z = cvt_pk_bf16(v1[0], v1[1]); w.w = cvt_pk_bf16(v1[2], v1[3]);
                    *(u32x4*)(rowp + bj * HALF) = w; } }
    }
};
}

constexpr int NWAVES = 8;
constexpr int NPHASE = 10;
constexpr size_t WS_WIN_T = 512 * MiB, WS_WUPA_T = 672 * MiB, WS_WUPB_T = 688 * MiB, WS_WOUT_T = 704 * MiB, WS_WFF1_T = 736 * MiB, WS_WFF2_T = 864 * MiB;
static_assert(WS_PROJ + (size_t)M * PITCH * 2 <= WS_WIN_T && WS_WIN_T + (size_t)PITCH * DM * 2 <= WS_WUPA_T && WS_WFF2_T + (size_t)DM * DFF * 2 <= WS_END, "ws map");
constexpr int CW_QUEUE = 64;
constexpr int CW_BAR = 4096;
constexpr int LDS_GEN = 0;
constexpr int MISC_OFF = 151 * 1024;
constexpr int LDS_BYTES = 152 * 1024;

#define LAS __attribute__((address_space(3)))
#define GAS __attribute__((address_space(1)))
typedef GAS unsigned gu32;
#define RLX_AGENT __ATOMIC_RELAXED, __HIP_MEMORY_SCOPE_AGENT
#define XB_TMO      128
#define XB_XCNT(j)  (256  + 64 * (j))
#define XB_XSUB(j)  (1280 + 64 * (j))
#define XB_XGEN(j)  (2304 + 64 * (j))
#define XB_TOP      3328
#define XB_TOPGEN   3392
#define XCD_BAR_WORDS 3456
#define XB_SPIN_CAP (1u << 18)

__device__ __forceinline__ unsigned xb_ld(unsigned* p)              { return __hip_atomic_load(p, __ATOMIC_RELAXED, __HIP_MEMORY_SCOPE_AGENT); }
__device__ __forceinline__ unsigned xb_add(unsigned* p, unsigned v) { return __hip_atomic_fetch_add(p, v, __ATOMIC_RELAXED, __HIP_MEMORY_SCOPE_AGENT); }
__device__ __forceinline__ unsigned xb_xcc_id() { return (unsigned)__builtin_amdgcn_s_getreg((3 << 11) | 20) & 0xFu; }
#define XB_SPIN(cond, bar) do { unsigned _sp = 0; while (cond) { __builtin_amdgcn_s_sleep(1); \
    if ((++_sp & 255u) == 0u) { if (xb_ld(&(bar)[XB_TMO])) break; if (_sp > XB_SPIN_CAP) { atomicAdd(&(bar)[XB_TMO], 1u); break; } } } } while (0)

struct XcdBarrier {
    unsigned* bar; unsigned x;
    volatile LAS unsigned* st;
};

__device__ __forceinline__ XcdBarrier xcd_barrier_post(unsigned* bar, volatile LAS unsigned* st, const int tid) {
    XcdBarrier b; b.bar = bar; b.x = xb_xcc_id(); b.st = st;
    if (tid == 0) (void)xb_add(&bar[XB_XCNT(b.x)], 1u);
    return b;
}
__device__ __forceinline__ void xcd_barrier_complete(unsigned* bar, unsigned x, unsigned& nloc, unsigned& nx) {
    const unsigned G = gridDim.x * gridDim.y * gridDim.z;
    unsigned sum, cnt, mine, sp = 0u;
    for (;;) {
        sum = 0u; cnt = 0u; mine = 0u;
#pragma unroll
        for (unsigned j = 0; j < 16; ++j) { const unsigned c = xb_ld(&bar[XB_XCNT(j)]); sum += c; cnt += (c > 0u) ? 1u : 0u; mine = (j == x) ? c : mine; }
        if (sum == G) break;
        __builtin_amdgcn_s_sleep(1);
        if ((++sp & 255u) == 0u) { if (xb_ld(&bar[XB_TMO])) break; if (sp > XB_SPIN_CAP) { atomicAdd(&bar[XB_TMO], 1u); break; } }
    }
    nloc = mine > 0u ? mine : 1u; nx = cnt > 0u ? cnt : 1u;
}

__device__ __forceinline__ void xcd_barrier(const XcdBarrier& b, const int tid) {
    asm volatile("s_waitcnt vmcnt(0)" ::: "memory");
    __syncthreads();
    if (tid == 0) {
        unsigned* bar = b.bar;
        __builtin_amdgcn_s_waitcnt(0);
        unsigned nloc = b.st[0], nx = b.st[1];
        if (nloc == 0u) { xcd_barrier_complete(bar, b.x, nloc, nx); b.st[0] = nloc; b.st[1] = nx; }
        const unsigned old = xb_add(&bar[XB_XSUB(b.x)], 1u);
        const unsigned gen = old / nloc;
        if (old + 1u == (gen + 1u) * nloc) {
            __builtin_amdgcn_fence(__ATOMIC_RELEASE, "agent");
            asm volatile("s_waitcnt vmcnt(0)" ::: "memory");
            const unsigned og = xb_add(&bar[XB_TOP], 1u);
            const unsigned tg = og / nx;
            if (og + 1u == (tg + 1u) * nx) xb_add(&bar[XB_TOPGEN], 1u);
            else XB_SPIN(xb_ld(&bar[XB_TOPGEN]) == tg, bar);
            __builtin_amdgcn_fence(__ATOMIC_ACQUIRE, "agent");
            xb_add(&bar[XB_XGEN(b.x)], 1u);
            asm volatile("s_waitcnt vmcnt(0)" ::: "memory");
        } else {
            XB_SPIN(xb_ld(&bar[XB_XGEN(b.x)]) == gen, bar);
            __builtin_amdgcn_fence(__ATOMIC_ACQUIRE, "agent");
            asm volatile("s_waitcnt vmcnt(0)" ::: "memory");
        }
    }
    __syncthreads();
}

static_assert(CW_BAR + 3 * XCD_BAR_WORDS <= (int)(WS_MOD / 4), "barrier words inside the zeroed CTL region, below MOD");

__device__ __forceinline__ unsigned cvt_pk_nv(float lo, float hi) { unsigned r; asm("v_cvt_pk_bf16_f32 %0, %1, %2" : "=v"(r) : "v"(lo), "v"(hi)); return r; }
struct TrDesc { const float* W; bf16_t* WT; int ldw, oldc0, K, new_r0, kb, ncols; float* cacc; };
__device__ __forceinline__ void tr_load(const TrDesc& d, f32x4 (&v)[16], int lane) {
    const int k0 = 64 * d.kb, l15 = lane & 15, lq = lane >> 4;
#pragma unroll
    for (int i = 0; i < 16; ++i) v[i] = *(const f32x4*)(d.W + (size_t)(k0 + 8 * (i >> 1) + 2 * lq + (i & 1)) * d.ldw + d.oldc0 + 4 * l15);
}
__device__ __forceinline__ void tr_finish(const TrDesc& d, const f32x4 (&v)[16], LAS float* scr_f, int lane) {
    LAS unsigned* scr = (LAS unsigned*)scr_f;
    const int k0 = 64 * d.kb, l15 = lane & 15, lq = lane >> 4;
    const int sw = (l15 & 7) << 2;
#pragma unroll
    for (int i = 0; i < 8; ++i) { const int kp = (4 * i + lq) ^ sw;
#pragma unroll
        for (int e = 0; e < 4; ++e) scr[(4 * l15 + e) * 32 + kp] = cvt_pk_nv(v[2 * i][e], v[2 * i + 1][e]); }
    asm volatile("s_waitcnt lgkmcnt(0)" ::: "memory");
    const int c = lane & 7;
    u32x4 o[8];
#pragma unroll
    for (int j = 0; j < 8; ++j) { const int n = (lane >> 3) + 8 * j; o[j] = *(const LAS u32x4*)(scr + n * 32 + 4 * (c ^ ((n >> 2) & 7))); }
#pragma unroll
    for (int j = 0; j < 8; ++j) { const int n = (lane >> 3) + 8 * j;
        if (n < d.ncols) *(u32x4*)(d.WT + (size_t)(d.new_r0 + n) * d.K + k0 + 8 * c) = o[j]; }
    asm volatile("s_waitcnt lgkmcnt(0)" ::: "memory");
}
__device__ __forceinline__ void tr_shiftdot(const TrDesc& d, const f32x4 (&v)[16], int lane, const LAS float* shl) {
    const int l15 = lane & 15, lq = lane >> 4;
    float a[4][4];
#pragma unroll
    for (int b = 0; b < 4; ++b)
#pragma unroll
        for (int e = 0; e < 4; ++e) a[b][e] = 0.f;
#pragma unroll
    for (int i = 0; i < 8; ++i)
#pragma unroll
        for (int b = 0; b < 4; ++b) { const pg8::f32x2 s = *(const LAS pg8::f32x2*)(shl + b * 64 + 8 * i + 2 * lq);
#pragma unroll
            for (int e = 0; e < 4; ++e) a[b][e] += s[0] * v[2 * i][e] + s[1] * v[2 * i + 1][e]; }
    const bool hi0 = lq & 1, hi1 = lq >> 1;
    float* dst = d.cacc + d.new_r0 + 4 * l15 + 2 * (lq & 1) + (lq >> 1);
#pragma unroll
    for (int b = 0; b < 4; ++b) {
        const float k0 = hi0 ? a[b][2] : a[b][0], k1 = hi0 ? a[b][3] : a[b][1];
        const float g0 = hi0 ? a[b][0] : a[b][2], g1 = hi0 ? a[b][1] : a[b][3];
        const float p0 = k0 + __shfl_xor(g0, 16), p1 = k1 + __shfl_xor(g1, 16);
        const float kk = hi1 ? p1 : p0, gg = hi1 ? p0 : p1;
        atomicAdd(dst + b * DFF, kk + __shfl_xor(gg, 32)); }
}
template <class Dec>
__device__ __forceinline__ void tr_run(const Dec& dec, int it0, int stride, int end, LAS float* scr, int lane, const LAS float* shl = nullptr) {
    if (it0 >= end) return;
    TrDesc da = dec(it0), db = da; f32x4 va[16], vb[16]; tr_load(da, va, lane);
    for (int it = it0;;) {
        int itn = it + stride; bool more = itn < end;
        db = dec(more ? itn : it); tr_load(db, vb, lane);
        tr_finish(da, va, scr, lane); if (shl && da.cacc) tr_shiftdot(da, va, lane, shl);
        if (!more) break;
        it = itn; itn = it + stride; more = itn < end;
        da = dec(more ? itn : it); tr_load(da, va, lane);
        tr_finish(db, vb, scr, lane); if (shl && db.cacc) tr_shiftdot(db, vb, lane, shl);
        if (!more) break;
        it = itn;
    }
}
constexpr int TI_IN = 306 * 64, TI_UP = 64 * 32, TI_OUT = 64 * 64, TI_FF1 = 256 * 64, TI_FF2 = 64 * 256;
constexpr int TI_C1 = 2 * 64, TI_C2 = 2 * 2;
constexpr int TI_A = TI_IN + 2 * TI_C1 + 2 * TI_C2;
constexpr int TI_B = 2 * TI_UP + TI_OUT + TI_FF1 + TI_FF2, TI_FF1_0 = 2 * TI_UP + TI_OUT + TI_FF2;
constexpr int CONV_KT = 13;
struct ConvB { const float *w_up_nsa, *w_up_fox, *w_out, *w_ff1, *w_ff2; bf16_t *WUPA_T, *WUPB_T, *WOUT_T, *WFF1_T, *WFF2_T; float* cbv; };
struct DecB { ConvB cb;
    __device__ __forceinline__ TrDesc operator()(int r) const {
        if (r < TI_UP) return TrDesc{cb.w_up_nsa, cb.WUPA_T, DM, (r % 64) * 64, 2048, (r % 64) * 64, r / 64, 64}; r -= TI_UP;
        if (r < TI_UP) return TrDesc{cb.w_up_fox, cb.WUPB_T, DM, (r % 64) * 64, 2048, (r % 64) * 64, r / 64, 64}; r -= TI_UP;
        if (r < TI_OUT) return TrDesc{cb.w_out, cb.WOUT_T, DM, (r % 64) * 64, DM, (r % 64) * 64, r / 64, 64}; r -= TI_OUT;
        if (r < TI_FF2) return TrDesc{cb.w_ff2, cb.WFF2_T, DM, (r % 64) * 64, DFF, (r % 64) * 64, r / 64, 64}; r -= TI_FF2;
        return TrDesc{cb.w_ff1, cb.WFF1_T, DFF, (r % 256) * 64, DM, (r % 256) * 64, r / 256, 64, cb.cbv};
    } };
struct DecA { const float *w_in, *w_cmp_k1, *w_cmp_v1, *w_cmp_k2, *w_cmp_v2; bf16_t *WIN_T, *WC1K_T, *WC1V_T, *WC2K_T, *WC2V_T;
    __device__ __forceinline__ TrDesc operator()(int r) const {
        if (r < TI_IN) { const int cb = r % 306, kb = r / 306; int oldc, newc, nc = 64;
            if (cb < 80) { oldc = cb * 64; newc = cb * 64; }
            else if (cb < 176) { oldc = 5168 + (cb - 80) * 64; newc = 5120 + (cb - 80) * 64; }
            else if (cb < 304) { oldc = 11328 + (cb - 176) * 64; newc = 11264 + (cb - 176) * 64; }
            else if (cb == 304) { oldc = 5120; newc = 19456; nc = 48; }
            else { oldc = 11312; newc = 19504; nc = 16; }
            return TrDesc{w_in, WIN_T, N_IN_OLD, oldc, DM, newc, kb, nc}; }
        r -= TI_IN;
        if (r < TI_C1) return TrDesc{w_cmp_k1, WC1K_T, 128, (r % 2) * 64, 4096, (r % 2) * 64, r / 2, 64}; r -= TI_C1;
        if (r < TI_C1) return TrDesc{w_cmp_v1, WC1V_T, 128, (r % 2) * 64, 4096, (r % 2) * 64, r / 2, 64}; r -= TI_C1;
        if (r < TI_C2) return TrDesc{w_cmp_k2, WC2K_T, 128, (r % 2) * 64, 128, (r % 2) * 64, r / 2, 64}; r -= TI_C2;
        return TrDesc{w_cmp_v2, WC2V_T, 128, (r % 2) * 64, 128, (r % 2) * 64, r / 2, 64};
    } };


__device__ __forceinline__ void post_row(bf16_t* proj, int row, const float* nq, const float* nk, const float* fqn, const float* fkn, const float* rope, int lane) {
    const int l16 = lane & 15, sg = lane >> 4, t = row % SEQ;
    bf16_t* rp = proj + (size_t)row * PITCH + 8 * l16;
    u32x4 raw[14];
#pragma unroll
    for (int p = 0; p < 14; ++p) { if (p < 4 || (p >= 6 && p < 10)) continue;
        const int slot = 4 * p + sg;
        const int col = p < 4 ? slot * 128 : p == 4 ? C_KS + (slot - 16) * 128 : p == 5 ? C_KW + (slot - 20) * 128 : p < 10 ? C_FQ + (slot - 24) * 128 : C_FK + (slot - 40) * 128;
        raw[p] = *(const u32x4*)(rp + col); }
#pragma unroll
    for (int p = 0; p < 14; ++p) { if (p < 4 || (p >= 6 && p < 10)) continue;
        const int slot = 4 * p + sg;
        const int col = p < 4 ? slot * 128 : p == 4 ? C_KS + (slot - 16) * 128 : p == 5 ? C_KW + (slot - 20) * 128 : p < 10 ? C_FQ + (slot - 24) * 128 : C_FK + (slot - 40) * 128;
        const float* g = p < 4 ? nq : p < 6 ? nk : p < 10 ? fqn : fkn;
        float v[8]; pg8::unpack8(raw[p], v);
        float ss = 0.f;
#pragma unroll
        for (int e = 0; e < 8; ++e) ss += v[e] * v[e];
        ss += __shfl_xor(ss, 1); ss += __shfl_xor(ss, 2); ss += __shfl_xor(ss, 4); ss += __shfl_xor(ss, 8);
        const float rstd = 1.0f / sqrtf(ss * (1.f / 128.f) + RMS_EPS);
        const f32x4 g0 = *(const f32x4*)(g + 8 * l16), g1 = *(const f32x4*)(g + 8 * l16 + 4);
#pragma unroll
        for (int e = 0; e < 4; ++e) { v[e] = v[e] * rstd * g0[e]; v[4 + e] = v[4 + e] * rstd * g1[e]; }
        if (p < 6) {
            float y[8];
#pragma unroll
            for (int e = 0; e < 8; ++e) y[e] = __shfl_xor(v[e], 2);
            if (l16 < 4) {
                const int i0 = (8 * l16) & 15;
                const f32x4 ca = *(const f32x4*)(rope + t * 16 + i0), cb = *(const f32x4*)(rope + t * 16 + i0 + 4);
                const f32x4 sa = *(const f32x4*)(rope + 2048 * 16 + t * 16 + i0), sb = *(const f32x4*)(rope + 2048 * 16 + t * 16 + i0 + 4);
#pragma unroll
                for (int e = 0; e < 8; ++e) { const float cc = e < 4 ? ca[e] : cb[e - 4], sn = e < 4 ? sa[e] : sb[e - 4];
                    v[e] = (l16 < 2) ? v[e] * cc - y[e] * sn : y[e] * sn + v[e] * cc; }
            }
        }
        u32x4 w; w.x = pg8::cvt_pk_bf16(v[0], v[1]); w.y = pg8::cvt_pk_bf16(v[2], v[3]); w.z = pg8::cvt_pk_bf16(v[4], v[5]); w.w = pg8::cvt_pk_bf16(v[6], v[7]);
        *(u32x4*)(rp + col) = w; }
}
typedef short bf16x8_t __attribute__((ext_vector_type(8)));
__device__ __forceinline__ float gelu_fast(float x) { const float u = 0.7978845608028654f * (x + 0.044715f * x * x * x); const float e = __expf(2.f * u); return 0.5f * x * (2.f - 2.f * __builtin_amdgcn_rcpf(e + 1.f)); }
__device__ __forceinline__ void compress_s1(int id, const bf16_t* proj, const bf16_t* w1k_t, const bf16_t* w1v_t, float* PB, int lane) {
    const int cu = id >> 6, mt = (id >> 3) & 7, ng = id & 7;
    const int which = cu >> 4, b = (cu >> 2) & 3, g = cu & 3;
    const int fr = lane & 15, fq = lane >> 4;
    const int lh = ng >> 2, j0 = ((2 * ng) & 7) * 16;
    const bf16_t* abase = proj + ((size_t)b * SEQ + 16 * (16 * mt + fr)) * PITCH + (which ? C_VC : C_KC) + g * 128 + 8 * fq;
    const bf16_t* bbase = (which ? w1v_t : w1k_t) + (size_t)(j0 + fr) * 4096 + lh * 2048 + 8 * fq;
    f32x4 a0 = (f32x4){0.f, 0.f, 0.f, 0.f}, a1 = (f32x4){0.f, 0.f, 0.f, 0.f};
    bf16x8_t fa[2][8], fb0[2][8], fb1[2][8];
#define CS1_LOAD(st, kb) _Pragma("unroll") for (int j = 0; j < 8; ++j) { const int ks = 8 * (kb) + j; \
        fa[st][j] = *(const bf16x8_t*)(abase + (size_t)(ks >> 2) * PITCH + (ks & 3) * 32); fb0[st][j] = *(const bf16x8_t*)(bbase + ks * 32); fb1[st][j] = *(const bf16x8_t*)(bbase + (size_t)16 * 4096 + ks * 32); }
#define CS1_MMA(st) _Pragma("unroll") for (int j = 0; j < 8; ++j) { a0 = __builtin_amdgcn_mfma_f32_16x16x32_bf16(fb0[st][j], fa[st][j], a0, 0, 0, 0); a1 = __builtin_amdgcn_mfma_f32_16x16x32_bf16(fb1[st][j], fa[st][j], a1, 0, 0, 0); }
#define CS1_SB __builtin_amdgcn_sched_barrier(0)
    CS1_LOAD(0, 0); CS1_SB;
#pragma unroll
    for (int kb = 0; kb < 8; kb += 2) {
        CS1_LOAD(1, kb + 1); CS1_SB; CS1_MMA(0); CS1_SB;
        if (kb + 2 < 8) { CS1_LOAD(0, kb + 2); } CS1_SB; CS1_MMA(1); CS1_SB;
    }
#undef CS1_LOAD
#undef CS1_MMA
#undef CS1_SB
    float* pp = PB + ((size_t)(cu * 2 + lh) * 128 + 16 * mt + fr) * 128 + j0 + 4 * fq;
    *(f32x4*)pp = a0; *(f32x4*)(pp + 16) = a1;
}
__device__ __forceinline__ void compress_s2(int which, const float* P0g, const float* P1g, const bf16_t* w2t, const float* c1, const float* nk, const float* rope, bf16_t* outp, int wave, int lane) {
    const int fr = lane & 15, fq = lane >> 4;
    const int n = 16 * wave + fr, n1 = n + 1 < 128 ? n + 1 : 127;
    f32x4 o[8];
#pragma unroll
    for (int i = 0; i < 8; ++i) o[i] = (f32x4){0.f, 0.f, 0.f, 0.f};
    f32x4 pv[4][6];
#pragma unroll
    for (int ks = 0; ks < 4; ++ks) { const int i0 = 32 * ks + 8 * fq;
        pv[ks][0] = *(const f32x4*)(P0g + n * 128 + i0); pv[ks][1] = *(const f32x4*)(P0g + n * 128 + i0 + 4);
        pv[ks][2] = *(const f32x4*)(P1g + n1 * 128 + i0); pv[ks][3] = *(const f32x4*)(P1g + n1 * 128 + i0 + 4);
        pv[ks][4] = *(const f32x4*)(c1 + i0); pv[ks][5] = *(const f32x4*)(c1 + i0 + 4); }
    __builtin_amdgcn_sched_barrier(0);
#pragma unroll
    for (int kh = 0; kh < 2; ++kh) {
        bf16x8_t wf[2][8];
#pragma unroll
        for (int kk = 0; kk < 2; ++kk)
#pragma unroll
            for (int nt = 0; nt < 8; ++nt) wf[kk][nt] = *(const bf16x8_t*)(w2t + (size_t)(nt * 16 + fr) * 128 + 32 * (2 * kh + kk) + 8 * fq);
        __builtin_amdgcn_sched_barrier(0);
#pragma unroll
        for (int kk = 0; kk < 2; ++kk) { const int ks = 2 * kh + kk;
            float h[8];
#pragma unroll
            for (int e = 0; e < 4; ++e) { h[e] = gelu_fast(pv[ks][0][e] + pv[ks][2][e] + pv[ks][4][e]); h[4 + e] = gelu_fast(pv[ks][1][e] + pv[ks][3][e] + pv[ks][5][e]); }
            u32x4 hw; hw.x = pg8::cvt_pk_bf16(h[0], h[1]); hw.y = pg8::cvt_pk_bf16(h[2], h[3]); hw.z = pg8::cvt_pk_bf16(h[4], h[5]); hw.w = pg8::cvt_pk_bf16(h[6], h[7]);
            const bf16x8_t af = __builtin_bit_cast(bf16x8_t, hw);
#pragma unroll
            for (int nt = 0; nt < 8; ++nt) o[nt] = __builtin_amdgcn_mfma_f32_16x16x32_bf16(wf[kk][nt], af, o[nt], 0, 0, 0); }
        __builtin_amdgcn_sched_barrier(0);
    }
    if (which == 0) {
        float ss = 0.f;
#pragma unroll
        for (int nt = 0; nt < 8; ++nt) ss += (o[nt][0] * o[nt][0] + o[nt][1] * o[nt][1]) + (o[nt][2] * o[nt][2] + o[nt][3] * o[nt][3]);
        ss += __shfl_xor(ss, 16); ss += __shfl_xor(ss, 32);
        const float rstd = 1.0f / sqrtf(ss * (1.f / 128.f) + RMS_EPS);
#pragma unroll
        for (int nt = 0; nt < 8; ++nt) { const f32x4 gg = *(const f32x4*)(nk + nt * 16 + 4 * fq); o[nt] = o[nt] * rstd * gg; }
        int t = 16 * n + 31; t = t < SEQ ? t : SEQ - 1;
        const f32x4 cc = *(const f32x4*)(rope + t * 16 + 4 * fq), sn = *(const f32x4*)(rope + 2048 * 16 + t * 16 + 4 * fq);
        const f32x4 x1 = o[0], x2 = o[1];
        o[0] = x1 * cc - x2 * sn; o[1] = x1 * sn + x2 * cc;
    }
#pragma unroll
    for (int nt = 0; nt < 8; ++nt) { u32x2 w; w.x = pg8::cvt_pk_bf16(o[nt][0], o[nt][1]); w.y = pg8::cvt_pk_bf16(o[nt][2], o[nt][3]);
        if (n >= NCMP) { w.x = 0u; w.y = 0u; }
        *(u32x2*)(outp + (size_t)n * 128 + nt * 16 + 4 * fq) = w; }
}

namespace att {
typedef short bf16x8 __attribute__((ext_vector_type(8)));
typedef short s16x4 __attribute__((ext_vector_type(4)));
typedef float f32x16 __attribute__((ext_vector_type(16)));
constexpr float LOG2E = 1.4426950408889634f;
constexpr float C2 = LOG2E * ATT_SCALE;
constexpr float THR = 8.f;
constexpr unsigned BIGW = 0x40000000u;
constexpr int SHM = 16384;
constexpr int L_V = 0, L_K = 32768, L_WS = 65536, L_GATE = 67584  , L_KB = 70656, L_PSUM = 71680, L_IMP = 104448, L_OFIN = 71680  , L_SELM = 137216, L_UN = 137472, L_Q = 137536;
#define KSWZ(row, colB) ((row) * 256 + ((colB) ^ (((row) & 7) << 4)))
__device__ __forceinline__ int v_st(int k, int c) { const int kk = (k & ~0xC) | ((k & 4) << 1) | ((k & 8) >> 1); return ((kk >> 3) * 4 + (c >> 5)) * 512 + ((kk & 7) * 32 + (c & 31)) * 2; }
__device__ __forceinline__ int v_rd_base(int lane) { return ((lane & 3) << 3) | (((lane >> 2) & 3) << 6) | (((lane >> 4) & 1) << 5) | (((lane >> 5) & 1) << 8); }
constexpr int v_rd_off(int d0, int ks, int half) { return d0 * 512 + ks * 4096 + half * 2048; }
__device__ __forceinline__ int crow(int r, int hi) { return (r & 3) + 8 * (r >> 2) + 4 * hi; }
__device__ __forceinline__ unsigned cvtpk(float lo, float hi) { unsigned r; asm("v_cvt_pk_bf16_f32 %0, %1, %2" : "=v"(r) : "v"(lo), "v"(hi)); return r; }
__device__ __forceinline__ void mask_tile(f32x16& p0, f32x16& p1, int dq, unsigned W) {
    const float NEG = -__builtin_inff();
#pragma unroll
    for (int r = 0; r < 16; ++r) { const int c = (r & 3) + 8 * (r >> 2);
        if ((unsigned)(dq - c) >= W) p0[r] = NEG;
        if ((unsigned)(dq - c - 32) >= W) p1[r] = NEG; }
}
template <bool PRE>
__device__ __forceinline__ void partialSM(f32x16& p0, f32x16& p1, float& m_reg, float& alpha) {
    float pmax = p0[0];
#pragma unroll
    for (int r = 1; r < 16; ++r) pmax = fmaxf(pmax, p0[r]);
#pragma unroll
    for (int r = 0; r < 16; ++r) pmax = fmaxf(pmax, p1[r]);
    { auto rr = __builtin_amdgcn_permlane32_swap(__float_as_uint(pmax), __float_as_uint(pmax), false, false);
      pmax = fmaxf(__uint_as_float(rr[0]), __uint_as_float(rr[1])); }
    float mn;
    if (__builtin_expect(__all((pmax - m_reg) * (PRE ? 1.f : ATT_SCALE) <= (PRE ? THR * LOG2E : THR)), 1)) { mn = m_reg; alpha = 1.f; }
    else { mn = fmaxf(m_reg, pmax); alpha = __builtin_amdgcn_exp2f((m_reg - mn) * (PRE ? 1.f : C2)); m_reg = mn; }
    if (PRE) {
#pragma unroll
        for (int r = 0; r < 16; ++r) { p0[r] = p0[r] - mn; p1[r] = p1[r] - mn; }
    } else {
        const float mnL = -mn * C2;
#pragma unroll
        for (int r = 0; r < 16; ++r) { p0[r] = fmaf(p0[r], C2, mnL); p1[r] = fmaf(p1[r], C2, mnL); }
    }
#pragma unroll
    for (int r = 0; r < 16; ++r) p0[r] = __builtin_amdgcn_exp2f(p0[r]);
}
__device__ __forceinline__ void packP(const f32x16& p0, const f32x16& p1, bf16x8& pa0, bf16x8& pa1, bf16x8& pa2, bf16x8& pa3) {
#define PK4(P, B_, OUT) do { unsigned a0 = cvtpk(P[B_+0], P[B_+1]), a1 = cvtpk(P[B_+2], P[B_+3]);                          \
        unsigned b0 = cvtpk(P[B_+4], P[B_+5]), b1 = cvtpk(P[B_+6], P[B_+7]);                                             \
        auto r0 = __builtin_amdgcn_permlane32_swap(a0, b0, false, false); auto r1 = __builtin_amdgcn_permlane32_swap(a1, b1, false, false); \
        u32x4 w = {r0[0], r1[0], r0[1], r1[1]}; OUT = __builtin_bit_cast(bf16x8, w); } while (0)
    PK4(p0, 0, pa0); PK4(p0, 8, pa1); PK4(p1, 0, pa2); PK4(p1, 8, pa3);
#undef PK4
}
__device__ __forceinline__ void finishSM(f32x16& p0, f32x16& p1, float alpha, float& l_reg, bf16x8& pa0, bf16x8& pa1, bf16x8& pa2, bf16x8& pa3) {
#pragma unroll
    for (int r = 0; r < 16; ++r) p1[r] = __builtin_amdgcn_exp2f(p1[r]);
    float ps = 0.f;
#pragma unroll
    for (int r = 0; r < 16; ++r) ps += p0[r];
#pragma unroll
    for (int r = 0; r < 16; ++r) ps += p1[r];
    { auto rr = __builtin_amdgcn_permlane32_swap(__float_as_uint(ps), __float_as_uint(ps), false, false);
      ps = __uint_as_float(rr[0]) + __uint_as_float(rr[1]); }
    l_reg = l_reg * alpha + ps;
    packP(p0, p1, pa0, pa1, pa2, pa3);
}
__device__ __forceinline__ void qkt(f32x16& p0, f32x16& p1, const LAS unsigned char* Kb, int r32, int hi, const bf16x8 (&qr)[8]) {
    p0 = f32x16{}; p1 = f32x16{};
    const LAS unsigned char* kb[4];
#pragma unroll
    for (int dd = 0; dd < 4; ++dd) kb[dd] = Kb + KSWZ(r32, (dd * 16 + hi * 8) * 2);
#pragma unroll
    for (int d0 = 0; d0 < 8; ++d0) { const LAS unsigned char* a = kb[d0 & 3] + (d0 >> 2) * 128;
        const bf16x8 b0 = *(const LAS bf16x8*)a;
        const bf16x8 b1 = *(const LAS bf16x8*)(a + 32 * 256);
        p0 = __builtin_amdgcn_mfma_f32_32x32x16_bf16(b0, qr[d0], p0, 0, 0, 0);
        p1 = __builtin_amdgcn_mfma_f32_32x32x16_bf16(b1, qr[d0], p1, 0, 0, 0);
        if (d0 == 3) __builtin_amdgcn_sched_barrier(0); }
}
__device__ __forceinline__ void pv_tile(f32x16 (&o)[4], int vb, bf16x8 pa0, bf16x8 pa1, bf16x8 pa2, bf16x8 pa3) {
#define TRRD(dst, off) asm volatile("ds_read_b64_tr_b16 %0, %1 offset:%2" : "=&v"(dst) : "v"(vb), "i"(off) : "memory")
#define PV_RD(S, d0) do { constexpr int b_ = v_rd_off(d0, 0, 0); \
        TRRD(S##l0, b_); TRRD(S##h0, b_ + 2048); TRRD(S##l1, b_ + 4096); TRRD(S##h1, b_ + 6144); TRRD(S##l2, b_ + 8192); TRRD(S##h2, b_ + 10240); TRRD(S##l3, b_ + 12288); TRRD(S##h3, b_ + 14336); } while (0)
#define PV_MM(S, d0) do { \
        o[d0] = __builtin_amdgcn_mfma_f32_32x32x16_bf16(pa0, (bf16x8){S##l0[0], S##l0[1], S##l0[2], S##l0[3], S##h0[0], S##h0[1], S##h0[2], S##h0[3]}, o[d0], 0, 0, 0);   \
        o[d0] = __builtin_amdgcn_mfma_f32_32x32x16_bf16(pa1, (bf16x8){S##l1[0], S##l1[1], S##l1[2], S##l1[3], S##h1[0], S##h1[1], S##h1[2], S##h1[3]}, o[d0], 0, 0, 0);   \
        o[d0] = __builtin_amdgcn_mfma_f32_32x32x16_bf16(pa2, (bf16x8){S##l2[0], S##l2[1], S##l2[2], S##l2[3], S##h2[0], S##h2[1], S##h2[2], S##h2[3]}, o[d0], 0, 0, 0);   \
        o[d0] = __builtin_amdgcn_mfma_f32_32x32x16_bf16(pa3, (bf16x8){S##l3[0], S##l3[1], S##l3[2], S##l3[3], S##h3[0], S##h3[1], S##h3[2], S##h3[3]}, o[d0], 0, 0, 0); } while (0)
#define PV_WAIT(n) do { asm volatile("s_waitcnt lgkmcnt(" #n ")" ::: "memory"); __builtin_amdgcn_sched_barrier(0); } while (0)
    s16x4 al0, al1, al2, al3, ah0, ah1, ah2, ah3, bl0, bl1, bl2, bl3, bh0, bh1, bh2, bh3;
    PV_RD(a, 0); PV_RD(b, 1);
    PV_WAIT(8); PV_MM(a, 0); __builtin_amdgcn_sched_barrier(0);
    PV_RD(a, 2);
    PV_WAIT(8); PV_MM(b, 1); __builtin_amdgcn_sched_barrier(0);
    PV_RD(b, 3);
    PV_WAIT(8); PV_MM(a, 2); __builtin_amdgcn_sched_barrier(0);
    PV_WAIT(0); PV_MM(b, 3);
#undef PV_WAIT
#undef PV_MM
#undef PV_RD
#undef TRRD
}
__device__ __forceinline__ void rescale(f32x16 (&o)[4], float alpha, LAS float* al_l, int r32, int hi) {
    if (__any(alpha < 1.f)) { if (hi == 0) al_l[r32] = alpha; asm volatile("s_waitcnt lgkmcnt(0)" ::: "memory");
#pragma unroll
        for (int r = 0; r < 16; ++r) { const float a = al_l[crow(r, hi)];
#pragma unroll
            for (int d = 0; d < 4; ++d) o[d][r] *= a; } }
}
enum { M_SEL = 0, M_WIN = 1, M_FOX = 2 };
__device__ __forceinline__ float quad_sum(float v) {
    v += __builtin_bit_cast(float, __builtin_amdgcn_update_dpp(0, __builtin_bit_cast(int, v), 0xB1, 0xf, 0xf, false));
    v += __builtin_bit_cast(float, __builtin_amdgcn_update_dpp(0, __builtin_bit_cast(int, v), 0x4E, 0xf, 0xf, false));
    return v;
}
template <int MODE>
__device__ __forceinline__ void attn_stream(LAS unsigned char* lds, const bf16_t* Kg, const bf16_t* Vg, unsigned tiles, const bf16x8 (&qr)[8], f32x16 (&o)[4], float& m_reg, float& l_reg,
                                            int qpos, int qlo, int qhi, unsigned mysel, const float* cumrow, int tid, int wid, int lane) {
    const int r32 = lane & 31, hi = lane >> 5;
    const int sr = tid >> 4, sc = (tid & 15) * 8;
    const int kws = KSWZ(sr, sc * 2), vst0 = v_st(sr, sc), vst1 = v_st(32 + sr, sc);
    const int vb0 = (int)(uintptr_t)(lds + L_V) + v_rd_base(lane);
    LAS float* al_l = (LAS float*)(lds + L_WS) + wid * 64 + 32;
    LAS float* kbl = (LAS float*)(lds + L_KB);
    bf16x8 sk0, sk1, sv0, sv1; float skb = 0.f;
    const unsigned toff = (unsigned)(sr * PITCH + sc) * 2u;
#define LOADT(jj) do { const char* kt_ = (const char*)Kg + (size_t)(jj) * (64 * PITCH * 2); const char* vt_ = (const char*)Vg + (size_t)(jj) * (64 * PITCH * 2); \
        sk0 = *(const bf16x8*)(kt_ + toff); sk1 = *(const bf16x8*)(kt_ + (size_t)32 * PITCH * 2 + toff); sv0 = *(const bf16x8*)(vt_ + toff); sv1 = *(const bf16x8*)(vt_ + (size_t)32 * PITCH * 2 + toff); \
        if (MODE == M_FOX && tid < 64) skb = -cumrow[64 * (jj) + tid] * LOG2E; } while (0)
#define WRITET(bf) do { *(LAS bf16x8*)(lds + L_K + (bf) * SHM + kws) = sk0; *(LAS bf16x8*)(lds + L_K + (bf) * SHM + kws + 32 * 256) = sk1; \
        *(LAS bf16x8*)(lds + L_V + (bf) * SHM + vst0) = sv0; *(LAS bf16x8*)(lds + L_V + (bf) * SHM + vst1) = sv1; \
        if (MODE == M_FOX && tid < 64) kbl[(bf) * 64 + tid] = skb; } while (0)
    int j = __builtin_ctz(tiles); tiles &= tiles - 1;
    LOADT(j); WRITET(0);
    __syncthreads();
    int buf = 0;
    for (;;) {
        const bool more = tiles != 0u; int jn = 0;
        if (more) { jn = __builtin_ctz(tiles); tiles &= tiles - 1; LOADT(jn); }
        const int kb = 64 * j;
        bool act;
        if (MODE == M_SEL) act = __any((mysel >> j) & 1u);
        else if (MODE == M_WIN) act = (kb <= qhi) && (kb + 63 >= qlo - 511);
        else act = kb <= qhi;
        if (act) {
            f32x16 p0, p1;
            qkt(p0, p1, lds + L_K + buf * SHM, r32, hi, qr);
            if (MODE == M_FOX) {
#pragma unroll
                for (int rg = 0; rg < 4; ++rg) { const f32x4 b0 = *(const LAS f32x4*)(kbl + buf * 64 + 8 * rg + 4 * hi), b1 = *(const LAS f32x4*)(kbl + buf * 64 + 32 + 8 * rg + 4 * hi);
#pragma unroll
                    for (int e = 0; e < 4; ++e) { p0[4 * rg + e] = fmaf(p0[4 * rg + e], C2, b0[e]); p1[4 * rg + e] = fmaf(p1[4 * rg + e], C2, b1[e]); } }
                if (kb + 63 > qlo) mask_tile(p0, p1, qpos - 4 * hi - kb, BIGW);
            } else if (MODE == M_WIN) {
                if (kb + 63 > qlo || kb <= qhi - 512) mask_tile(p0, p1, qpos - 4 * hi - kb, 512u);
            } else {
                if (kb + 63 > qlo) mask_tile(p0, p1, qpos - 4 * hi - kb, BIGW);
                if (!((mysel >> j) & 1u)) { const float NEG = -__builtin_inff();
#pragma unroll
                    for (int r = 0; r < 16; ++r) { p0[r] = NEG; p1[r] = NEG; } }
            }
            float alpha;
            partialSM<MODE == M_FOX>(p0, p1, m_reg, alpha);
            rescale(o, alpha, al_l, r32, hi);
            bf16x8 pa0, pa1, pa2, pa3;
            finishSM(p0, p1, alpha, l_reg, pa0, pa1, pa2, pa3);
            pv_tile(o, vb0 + buf * SHM, pa0, pa1, pa2, pa3);
        }
        if (more) WRITET(buf ^ 1);
        __syncthreads();
        if (!more) break;
        j = jn; buf ^= 1;
    }
#undef LOADT
#undef WRITET
}
template <int STAGE>
__device__ __forceinline__ void fold(LAS unsigned* ofin_l, const f32x16 (&o)[4], float fac, LAS float* li_l, int r32, int hi) {
    if (hi == 0) li_l[r32] = fac; asm volatile("s_waitcnt lgkmcnt(0)" ::: "memory");
#pragma unroll
    for (int r = 0; r < 16; r += 2) { const float f0 = li_l[crow(r, hi)], f1 = li_l[crow(r + 1, hi)];
#pragma unroll
        for (int d = 0; d < 4; ++d) { float a = o[d][r] * f0, c = o[d][r + 1] * f1; LAS unsigned* sl = ofin_l + (d * 8 + (r >> 1)) * 512;
            if (STAGE == 1) { const unsigned w = *sl; a += __uint_as_float(w << 16); c += __uint_as_float(w & 0xffff0000u); }
            *sl = cvtpk(a, c); } }
    asm volatile("s_waitcnt lgkmcnt(0)" ::: "memory");
}
template <bool ROPE>
__device__ __forceinline__ void q_prep(bf16x8 (&qr)[8], const float* gain, const float* rope, int t, int hi) {
    f32x4 gg[8][2];
#pragma unroll
    for (int d0 = 0; d0 < 8; ++d0) { gg[d0][0] = *(const f32x4*)(gain + 16 * d0 + 8 * hi); gg[d0][1] = *(const f32x4*)(gain + 16 * d0 + 8 * hi + 4); }
    __builtin_amdgcn_sched_barrier(0);
    float v[8][8]; float ss = 0.f;
#pragma unroll
    for (int d0 = 0; d0 < 8; ++d0) { const u32x4 w = __builtin_bit_cast(u32x4, qr[d0]);
#pragma unroll
        for (int e = 0; e < 4; ++e) { v[d0][2 * e] = __uint_as_float(w[e] << 16); v[d0][2 * e + 1] = __uint_as_float(w[e] & 0xffff0000u); }
#pragma unroll
        for (int e = 0; e < 8; ++e) ss += v[d0][e] * v[d0][e]; }
    { auto rr = __builtin_amdgcn_permlane32_swap(__float_as_uint(ss), __float_as_uint(ss), false, false); ss = __uint_as_float(rr[0]) + __uint_as_float(rr[1]); }
    const float rstd = 1.0f / sqrtf(ss * (1.f / 128.f) + RMS_EPS);
#pragma unroll
    for (int d0 = 0; d0 < 8; ++d0) { const f32x4 g0 = gg[d0][0], g1 = gg[d0][1];
#pragma unroll
        for (int e = 0; e < 4; ++e) { v[d0][e] = v[d0][e] * rstd * g0[e]; v[d0][4 + e] = v[d0][4 + e] * rstd * g1[e]; } }
    if (ROPE) {
        const f32x4 ca = *(const f32x4*)(rope + t * 16 + 8 * hi), cb = *(const f32x4*)(rope + t * 16 + 8 * hi + 4);
        const f32x4 sa = *(const f32x4*)(rope + 2048 * 16 + t * 16 + 8 * hi), sb = *(const f32x4*)(rope + 2048 * 16 + t * 16 + 8 * hi + 4);
#pragma unroll
        for (int e = 0; e < 8; ++e) { const float cc = e < 4 ? ca[e] : cb[e - 4], sn = e < 4 ? sa[e] : sb[e - 4];
            const float x1 = v[0][e], x2 = v[1][e]; v[0][e] = x1 * cc - x2 * sn; v[1][e] = x1 * sn + x2 * cc; }
    }
#pragma unroll
    for (int d0 = 0; d0 < 8; ++d0) { u32x4 w; w.x = cvtpk(v[d0][0], v[d0][1]); w.y = cvtpk(v[d0][2], v[d0][3]); w.z = cvtpk(v[d0][4], v[d0][5]); w.w = cvtpk(v[d0][6], v[d0][7]);
        qr[d0] = __builtin_bit_cast(bf16x8, w); }
}
__device__ __forceinline__ void nsa_unit(LAS unsigned char* lds, int b, int g, int u, const bf16_t* proj, const float* small, const bf16_t* kcmp, const bf16_t* vcmp, const float* nqn, const float* rope, bf16_t* onsa, int tid, int wid, int lane) {
    const int r32 = lane & 31, hi = lane >> 5;
    const int q0 = 64 * u, tokl = 8 * wid + (r32 >> 2), qpos = q0 + tokl, qlo = q0 + 8 * wid, qhi = qlo + 7, head = g * 4 + (r32 & 3);
    const size_t row = (size_t)b * SEQ + qpos;
    LAS float* li_l = (LAS float*)(lds + L_WS) + wid * 64;
    LAS float* psum = (LAS float*)(lds + L_PSUM); LAS float* imp = (LAS float*)(lds + L_IMP); LAS unsigned* selm = (LAS unsigned*)(lds + L_SELM); LAS unsigned* un = (LAS unsigned*)(lds + L_UN);
    bf16x8 qr[8];
#pragma unroll
    for (int d0 = 0; d0 < 8; ++d0) qr[d0] = *(const bf16x8*)(proj + row * PITCH + C_NSAQ + head * 128 + d0 * 16 + hi * 8);
    const float* gl = small + row * 64 + head * 3;
    const float gl0 = gl[0], gl1 = gl[1], gl2 = gl[2];
    bf16x8 ck[2][4];
    { const int sr_ = tid >> 4, sc_ = (tid & 15) * 8; const bf16_t* kc_ = kcmp + (size_t)(b * 4 + g) * 128 * 128; const bf16_t* vc_ = vcmp + (size_t)(b * 4 + g) * 128 * 128;
#pragma unroll
      for (int tl = 0; tl < 2; ++tl) { const size_t ro = (size_t)(64 * tl + sr_) * 128 + sc_;
          ck[tl][0] = *(const bf16x8*)(kc_ + ro); ck[tl][1] = *(const bf16x8*)(kc_ + ro + 32 * 128); ck[tl][2] = *(const bf16x8*)(vc_ + ro); ck[tl][3] = *(const bf16x8*)(vc_ + ro + 32 * 128); } }
    __builtin_amdgcn_sched_barrier(0);
    q_prep<true>(qr, nqn, rope, qpos, hi);
    const float g0 = pg8::sigm(gl0);
    LAS float* gate_l = (LAS float*)(lds + L_GATE) + wid * 64;
    if (hi == 0) { gate_l[r32] = pg8::sigm(gl1); gate_l[32 + r32] = pg8::sigm(gl2); }
    f32x16 o[4]; float fac0;
    LAS unsigned* ofin_l = (LAS unsigned*)(lds + L_OFIN) + tid;
    {
        const int sr = tid >> 4, sc = (tid & 15) * 8;
        const int kws = KSWZ(sr, sc * 2), vst0 = v_st(sr, sc), vst1 = v_st(32 + sr, sc);
#pragma unroll
        for (int tl = 0; tl < 2; ++tl) { const bf16x8 k0 = ck[tl][0], k1 = ck[tl][1], v0 = ck[tl][2], v1 = ck[tl][3];
            *(LAS bf16x8*)(lds + L_K + tl * SHM + kws) = k0; *(LAS bf16x8*)(lds + L_K + tl * SHM + kws + 32 * 256) = k1;
            *(LAS bf16x8*)(lds + L_V + tl * SHM + vst0) = v0; *(LAS bf16x8*)(lds + L_V + tl * SHM + vst1) = v1; }
        __syncthreads();
        f32x16 a0, a1, b0, b1;
        qkt(a0, a1, lds + L_K, r32, hi, qr); qkt(b0, b1, lds + L_K + SHM, r32, hi, qr);
        const int vp = (qpos - 31) >> 4;
        mask_tile(a0, a1, vp - 4 * hi, BIGW); mask_tile(b0, b1, vp - 4 * hi - 64, BIGW);
        float mx = a0[0];
#pragma unroll
        for (int r = 0; r < 16; ++r) mx = fmaxf(fmaxf(mx, a0[r]), fmaxf(a1[r], fmaxf(b0[r], b1[r])));
        { auto rr = __builtin_amdgcn_permlane32_swap(__float_as_uint(mx), __float_as_uint(mx), false, false); mx = fmaxf(__uint_as_float(rr[0]), __uint_as_float(rr[1])); }
        if (mx == -__builtin_inff()) mx = 0.f;
        const float mnL = -mx * C2; float ps = 0.f;
#pragma unroll
        for (int r = 0; r < 16; ++r) { a0[r] = __builtin_amdgcn_exp2f(fmaf(a0[r], C2, mnL)); a1[r] = __builtin_amdgcn_exp2f(fmaf(a1[r], C2, mnL));
            b0[r] = __builtin_amdgcn_exp2f(fmaf(b0[r], C2, mnL)); b1[r] = __builtin_amdgcn_exp2f(fmaf(b1[r], C2, mnL)); ps += (a0[r] + a1[r]) + (b0[r] + b1[r]); }
        { auto rr = __builtin_amdgcn_permlane32_swap(__float_as_uint(ps), __float_as_uint(ps), false, false); ps = __uint_as_float(rr[0]) + __uint_as_float(rr[1]); }
        const float rl = ps > 0.f ? 1.f / ps : 0.f;
#pragma unroll
        for (int r = 0; r < 16; ++r) { const int key = crow(r, hi);
            float v0 = a0[r] * rl, v1 = a1[r] * rl, v2 = b0[r] * rl, v3 = b1[r] * rl;
            v0 = quad_sum(v0); v1 = quad_sum(v1); v2 = quad_sum(v2); v3 = quad_sum(v3);
            if ((r32 & 3) == 0) { LAS float* pp = psum + tokl * 128 + key; pp[0] = v0; pp[32] = v1; pp[64] = v2; pp[96] = v3; } }
        bf16x8 pa0, pa1, pa2, pa3;
        const int vb0 = (int)(uintptr_t)(lds + L_V) + v_rd_base(lane);
#pragma unroll
        for (int d = 0; d < 4; ++d) o[d] = f32x16{};
        packP(a0, a1, pa0, pa1, pa2, pa3); pv_tile(o, vb0, pa0, pa1, pa2, pa3);
        packP(b0, b1, pa0, pa1, pa2, pa3); pv_tile(o, vb0 + SHM, pa0, pa1, pa2, pa3);
        fac0 = g0 * rl;
        __syncthreads();
    }
    {
        const int tk = tid >> 3, jg = tid & 7; const float NINF = -__builtin_inff();
        float sc4[4];
#pragma unroll
        for (int jj = 0; jj < 4; ++jj) { const int j = jg * 4 + jj; float im = 0.f;
#pragma unroll
            for (int i = -1; i <= 3; ++i) { const int ci = 4 * j + i; if (ci >= 0 && ci < NCMP) im += psum[tk * 128 + ci]; }
            const bool forced = (j == 0) || (j == u) || (j == u - 1); const bool causal = j <= u;
            sc4[jj] = forced ? __builtin_inff() : (causal ? im : NINF); imp[tk * 32 + j] = sc4[jj]; }
        asm volatile("s_waitcnt lgkmcnt(0)" ::: "memory");
        unsigned bits = 0u;
        f32x4 sv[8];
#pragma unroll
        for (int q = 0; q < 8; ++q) sv[q] = *(const LAS f32x4*)(imp + tk * 32 + 4 * q);
#pragma unroll
        for (int jj = 0; jj < 4; ++jj) { const int j = jg * 4 + jj; const float sj = sc4[jj]; int rank = 0;
#pragma unroll
            for (int k = 0; k < 32; ++k) { const float sk = sv[k >> 2][k & 3]; rank += (sk > sj || (sk == sj && k < j)) ? 1 : 0; }
            if (rank < 16 && sj > NINF) bits |= 1u << j; }
        bits |= __shfl_xor(bits, 1); bits |= __shfl_xor(bits, 2); bits |= __shfl_xor(bits, 4);
        if (jg == 0) selm[tk] = bits;
        unsigned ub = bits; ub |= __shfl_xor(ub, 8); ub |= __shfl_xor(ub, 16); ub |= __shfl_xor(ub, 32);
        if (lane == 0) un[wid] = ub;
        __syncthreads();
    }
    fold<0>(ofin_l, o, fac0, li_l, r32, hi);
    const unsigned mysel = selm[tokl];
    unsigned uni = 0u;
#pragma unroll
    for (int w = 0; w < 8; ++w) uni |= un[w];
    uni = __builtin_amdgcn_readfirstlane(uni);
    {
        float m_reg = -1e30f, l_reg = 0.f;
#pragma unroll
        for (int d = 0; d < 4; ++d) o[d] = f32x16{};
        const bf16_t* Kg = proj + (size_t)b * SEQ * PITCH + C_KS + g * 128; const bf16_t* Vg = proj + (size_t)b * SEQ * PITCH + C_VS + g * 128;
        attn_stream<M_SEL>(lds, Kg, Vg, uni, qr, o, m_reg, l_reg, qpos, qlo, qhi, mysel, nullptr, tid, wid, lane);
        fold<1>(ofin_l, o, l_reg > 0.f ? gate_l[r32] / l_reg : 0.f, li_l, r32, hi);
    }
    {
        float m_reg = -1e30f, l_reg = 0.f;
#pragma unroll
        for (int d = 0; d < 4; ++d) o[d] = f32x16{};
        const int jlo = u >= 8 ? u - 8 : 0;
        const unsigned tiles = (u == 31 ? 0xffffffffu : ((1u << (u + 1)) - 1u)) & ~((1u << jlo) - 1u);
        const bf16_t* Kg = proj + (size_t)b * SEQ * PITCH + C_KW + g * 128; const bf16_t* Vg = proj + (size_t)b * SEQ * PITCH + C_VW + g * 128;
        attn_stream<M_WIN>(lds, Kg, Vg, tiles, qr, o, m_reg, l_reg, qpos, qlo, qhi, 0u, nullptr, tid, wid, lane);
        if (hi == 0) li_l[r32] = l_reg > 0.f ? gate_l[32 + r32] / l_reg : 0.f; asm volatile("s_waitcnt lgkmcnt(0)" ::: "memory");
        LAS bf16_t* stg = (LAS bf16_t*)(lds + wid * 8192);
#pragma unroll
        for (int r = 0; r < 16; ++r) { const int rr = crow(r, hi); const float f = li_l[rr];
#pragma unroll
            for (int d = 0; d < 4; ++d) { const unsigned w = ofin_l[(d * 8 + (r >> 1)) * 512];
                const float v = ((r & 1) ? __uint_as_float(w & 0xffff0000u) : __uint_as_float(w << 16)) + o[d][r] * f;
                stg[rr * 128 + d * 32 + r32] = (bf16_t)cvtpk(v, 0.f); } }
        asm volatile("s_waitcnt lgkmcnt(0)" ::: "memory");
#pragma unroll
        for (int i = 0; i < 8; ++i) { const int rr = i * 4 + (lane >> 4), ch = lane & 15;
            const u32x4 w = *(const LAS u32x4*)(stg + rr * 128 + ch * 8);
            *(u32x4*)(onsa + ((size_t)b * SEQ + q0 + 8 * wid + (rr >> 2)) * 2048 + (g * 4 + (rr & 3)) * 128 + ch * 8) = w; }
        asm volatile("s_waitcnt lgkmcnt(0)" ::: "memory");
    }
}
__device__ __forceinline__ void fox_unit(LAS unsigned char* lds, int b, int h, int qb, const bf16_t* proj, const float* cum, const float* fqn, const float* fkn, bf16_t* ofox, int tid, int wid, int lane) {
    const int r32 = lane & 31, hi = lane >> 5;
    const int q0 = 256 * qb, qlo = q0 + 32 * wid, qpos = qlo + r32, qhi = qlo + 31;
    const size_t row = (size_t)b * SEQ + qpos;
    LAS float* li_l = (LAS float*)(lds + L_WS) + wid * 64;
    bf16x8 qr[8];
#pragma unroll
    for (int d0 = 0; d0 < 8; ++d0) qr[d0] = *(const bf16x8*)(proj + row * PITCH + C_FQ + h * 128 + d0 * 16 + hi * 8);
    const float* cumrow = cum + (size_t)(b * 16 + h) * SEQ;
    const int nt = 4 * (qb + 1);
    const float fq0_ = fqn[lane], fq1_ = fqn[lane + 64], fk0_ = fkn[lane], fk1_ = fkn[lane + 64];
    const float cj_ = ((lane & 31) < nt) ? cumrow[64 * (lane & 31) + 63] : 0.f, cq_ = cumrow[q0];
    __builtin_amdgcn_sched_barrier(0);
    q_prep<false>(qr, fqn, nullptr, 0, hi);
    f32x16 o[4];
#pragma unroll
    for (int d = 0; d < 4; ++d) o[d] = f32x16{};
    float m_reg = -1e30f, l_reg = 0.f;
    unsigned tiles;
    { float gq = fmaxf(fabsf(fq0_), fabsf(fq1_)), gk = fmaxf(fabsf(fk0_), fabsf(fk1_));
      gq = wave_max(gq); gk = wave_max(gk);
      const float bound = 2.f * 128.f * 1.02f * gq * gk * C2 + 170.f;
      const int j = lane & 31; const float gap = (j < nt) ? (cj_ - cq_) * LOG2E : 0.f;
      tiles = (unsigned)__ballot((j < nt) && !(gap > bound)); }
    tiles = (unsigned)__builtin_amdgcn_readfirstlane((int)tiles);
    const bf16_t* Kg = proj + (size_t)b * SEQ * PITCH + C_FK + h * 128; const bf16_t* Vg = proj + (size_t)b * SEQ * PITCH + C_FV + h * 128;
    attn_stream<M_FOX>(lds, Kg, Vg, tiles, qr, o, m_reg, l_reg, qpos, qlo, qhi, 0u, cumrow, tid, wid, lane);
    if (hi == 0) li_l[r32] = l_reg > 0.f ? 1.f / l_reg : 0.f; asm volatile("s_waitcnt lgkmcnt(0)" ::: "memory");
    LAS bf16_t* stg = (LAS bf16_t*)(lds + wid * 8192);
#pragma unroll
    for (int r = 0; r < 16; ++r) { const int rr = crow(r, hi); const float f = li_l[rr];
#pragma unroll
        for (int d = 0; d < 4; ++d) stg[rr * 128 + d * 32 + r32] = (bf16_t)cvtpk(o[d][r] * f, 0.f); }
    asm volatile("s_waitcnt lgkmcnt(0)" ::: "memory");
#pragma unroll
    for (int i = 0; i < 8; ++i) { const int rr = i * 4 + (lane >> 4), ch = lane & 15;
        const u32x4 w = *(const LAS u32x4*)(stg + rr * 128 + ch * 8);
        *(u32x4*)(ofox + ((size_t)b * SEQ + qlo + rr) * 2048 + h * 128 + ch * 8) = w; }
    asm volatile("s_waitcnt lgkmcnt(0)" ::: "memory");
}
#undef KSWZ
}

__device__ __forceinline__ int fresh_lane() { int l; asm volatile("v_mbcnt_lo_u32_b32 %0, -1, 0\n\tv_mbcnt_hi_u32_b32 %0, -1, %0" : "=v"(l)); return l; }

#ifndef PROBE_DUP
#define PROBE_DUP -1
#endif
#define REPS(k) for (int rep_ = 0; rep_ < ((PROBE_DUP == (k)) ? 2 : 1); ++rep_)
#define REP_SEAM(k) do { if (PROBE_DUP == (k) && rep_ == 0) { FRESH(); xcd_barrier(bar, tid); } } while (0)

struct Args { const float* in[23]; float* out; unsigned char* ws; int ph_lo, ph_hi, li, pad; };

__global__ void __launch_bounds__(NWAVES * 64, 2) mega_fwd(Args args) {
    extern __shared__ __attribute__((aligned(16))) unsigned char lds_raw[];
    LAS unsigned char* lds = (LAS unsigned char*)lds_raw;
    volatile LAS unsigned* MISC = (volatile LAS unsigned*)(lds + MISC_OFF);
    const int wave = __builtin_amdgcn_readfirstlane((int)threadIdx.x >> 6);
#define FRESH() const int lane = fresh_lane(); const int tid = wave * 64 + lane; (void)lane; (void)tid
    const int G = gridDim.x; const int bx = blockIdx.x; const int vcu = (G % 8 == 0) ? (bx % 8) * (G / 8) + bx / 8 : bx;
    unsigned char* ws = args.ws;
    gu32* ctl = (gu32*)(ws + WS_CTL);
    const float* x = args.in[0]; const float* c = args.in[1]; const float* w_ada = args.in[2]; const float* b_ada = args.in[3];
    const float* norm1_g = args.in[4]; const float* norm2_g = args.in[5]; const float* w_in = args.in[6];
    const float* b_forget = args.in[7]; const float* nsa_q_norm = args.in[8]; const float* nsa_k_norm = args.in[9]; const float* fox_q_norm = args.in[10]; const float* fox_k_norm = args.in[11];
    const float* w_cmp_k2 = args.in[15]; const float* w_cmp_v2 = args.in[17];
    const float* cmp_pos_k = args.in[12]; const float* cmp_pos_v = args.in[13]; const float* w_cmp_k1 = args.in[14]; const float* w_cmp_v1 = args.in[16];
    const float* w_up_nsa = args.in[18]; const float* w_up_fox = args.in[19]; const float* w_out = args.in[20]; const float* w_ff1 = args.in[21]; const float* w_ff2 = args.in[22];
    float* out = args.out;
    float* mod = (float*)(ws + WS_MOD); float* c1 = (float*)(ws + WS_C1); float* rope = (float*)(ws + WS_ROPE); float* small = (float*)(ws + WS_SMALL);
    float* ssq = (float*)(ws + WS_SS); float* cbv = (float*)(ws + WS_CB);
    bf16_t* H = (bf16_t*)(ws + WS_H); bf16_t* onsa = (bf16_t*)(ws + WS_ONSA); bf16_t* ofox = (bf16_t*)(ws + WS_OFOX);
    bf16_t* Y = (bf16_t*)(ws + WS_Y); bf16_t* proj = (bf16_t*)(ws + WS_PROJ); bf16_t* Abuf = (bf16_t*)(ws + WS_A);
    bf16_t* WIN_T = (bf16_t*)(ws + WS_WIN_T); bf16_t* WUPA_T = (bf16_t*)(ws + WS_WUPA_T); bf16_t* WUPB_T = (bf16_t*)(ws + WS_WUPB_T);
    bf16_t* WC1K_T = (bf16_t*)(ws + WS_WC1K_T); bf16_t* WC1V_T = (bf16_t*)(ws + WS_WC1V_T); bf16_t* WC2K_T = (bf16_t*)(ws + WS_WC2K_T); bf16_t* WC2V_T = (bf16_t*)(ws + WS_WC2V_T);
    bf16_t* kcmp = (bf16_t*)(ws + WS_KCMP); bf16_t* vcmp = (bf16_t*)(ws + WS_VCMP); float* cum = (float*)(ws + WS_CUM);
    bf16_t* WOUT_T = (bf16_t*)(ws + WS_WOUT_T); bf16_t* WFF1_T = (bf16_t*)(ws + WS_WFF1_T); bf16_t* WFF2_T = (bf16_t*)(ws + WS_WFF2_T);

    XcdBarrier bar;
    { FRESH(); for (int u = tid; u < (LDS_BYTES - MISC_OFF) / 4; u += NWAVES * 64) ((LAS unsigned*)(lds + MISC_OFF))[u] = 0u;
      __syncthreads();
      bar = xcd_barrier_post((unsigned*)(ctl + CW_BAR) + args.li * XCD_BAR_WORDS, MISC + 8, tid); }
    const int lo = args.ph_lo, hi = args.ph_hi;
    const int nshort = (G - ((M / 256) * (PITCH / 256)) % G) % G;
    const int nbt0_ = (nshort * NWAVES * CONV_KT < TI_FF1_0) ? nshort * NWAVES * CONV_KT : TI_FF1_0; const int nbt = nbt0_ & ~255;
    const int nconv = (TI_B - nbt + 63) / 64;
#define IN(k) (lo <= (k) && (k) < hi)
#define SEAM(k) do { if (IN(k) && IN((k) + 1)) { FRESH(); xcd_barrier(bar, tid); } } while (0)

    if (IN(0)) { FRESH();
        float* red = (float*)lds_raw;
        for (int u = bx; u < 96 * 8; u += G) adaln_unit(u, c, w_ada, b_ada, mod, red, red + 8 * 4 * 256);
        const int gid = vcu * 512 + tid;
        if (gid < 2048 * 16) {
            const int pos = gid >> 4, i = gid & 15;
            double f = 1.0; for (int k = 0; k < i; ++k) f *= 0.44036660267178046;
            const float inv = (float)f; const float ang = (float)pos * inv;
            float s_, c_; sincos_turns((double)ang * 0.15915494309189533577, s_, c_);
            rope[gid] = c_; rope[2048 * 16 + gid] = s_;
        }
        if (gid < 2 * 32 * 128) {
            const int j = gid & 127, kc = (gid >> 7) & 31, which = gid >> 12;
            const float* pos = which ? cmp_pos_v : cmp_pos_k; const float* w = which ? w_cmp_v1 : w_cmp_k1;
            float a = 0.f;
            for (int k = kc * 128; k < kc * 128 + 128; ++k) a += pos[k] * w[(size_t)k * 128 + j];
            atomicAdd(c1 + which * 128 + j, a);
        }
    }
    SEAM(0);
    if (IN(1)) REPS(1) { FRESH();
        const int gw = vcu * NWAVES + wave, NGW = G * NWAVES;
        for (int row = gw; row < M; row += NGW) { const int b = row / SEQ;
            norm_mod_row(x + (size_t)row * DM, norm1_g, mod + b * 24576 + 1 * DM, mod + b * 24576 + 0 * DM, H + (size_t)row * DM, lane); }
        LAS float* scr = (LAS float*)(lds + wave * (64 * 65 * 4));
        { const DecA da{w_in, w_cmp_k1, w_cmp_v1, w_cmp_k2, w_cmp_v2, WIN_T, WC1K_T, WC1V_T, WC2K_T, WC2V_T}; tr_run(da, gw, NGW, TI_A, scr, lane); }
    REP_SEAM(1); }
    SEAM(1);
    if (IN(2)) REPS(2) { FRESH();
        pg8::Gemm g{H, WIN_T, M, PITCH, DM}; pg8::StaticOrder S; S.init(M, PITCH, G, bx);
        pg8::EpiProjF E{proj, small};
        pg8::gemm_phase<pg8::EpiProjF, pg8::StaticOrder, true, true>(lds, g, S, E, tid);
        if (PROBE_DUP != 2 || rep_ == 0) {
        if (nshort > 0 && bx >= G - nshort) {
            const DecB db{ConvB{w_up_nsa, w_up_fox, w_out, w_ff1, w_ff2, WUPA_T, WUPB_T, WOUT_T, WFF1_T, WFF2_T, cbv}};
            const int lane2 = fresh_lane(); LAS float* scr = (LAS float*)(lds + wave * (64 * 65 * 4));
            tr_run(db, (bx - (G - nshort)) * NWAVES + wave, nshort * NWAVES, nbt, scr, lane2);
        } }
    REP_SEAM(2); }
    SEAM(2);
    if (IN(3)) { FRESH();
        float* PB = (float*)(ws + WS_Y);
        const int gw = bx * NWAVES + wave, NGW = G * NWAVES;
        for (int id = gw; id < 32 * 64; id += NGW) compress_s1(id, proj, WC1K_T, WC1V_T, PB, lane);
        { FRESH(); xcd_barrier(bar, tid); }
        const int ncb = G > 64 ? 32 : 0;
        if (ncb == 0 || bx < ncb)
            for (int cu = bx; cu < 32; cu += (ncb ? ncb : G)) { const int which = cu >> 4;
                compress_s2(which, PB + (size_t)(cu * 2) * 128 * 128, PB + (size_t)(cu * 2 + 1) * 128 * 128, which ? WC2V_T : WC2K_T, c1 + which * 128, nsa_k_norm, rope,
                            (which ? vcmp : kcmp) + (size_t)(cu & 15) * 128 * 128, wave, lane); }
        if (ncb && bx < ncb) { if (wave < 2) cumsum_bh(bx * 2 + wave, small, b_forget, cum, lane); }
        if (bx >= ncb) {
            const int gw2 = (bx - ncb) * NWAVES + wave, NGW2 = (G - ncb) * NWAVES;
            if (!ncb) for (int bh = gw2; bh < 64; bh += NGW2) cumsum_bh(bh, small, b_forget, cum, lane);
            for (int row = gw2; row < M; row += NGW2) post_row(proj, row, nsa_q_norm, nsa_k_norm, fox_q_norm, fox_k_norm, rope, lane);
        }
    }
    SEAM(3);
    if (IN(4)) REPS(4) { FRESH();
        LAS unsigned* qslot = (LAS unsigned*)(lds + att::L_Q);
        const unsigned ncp = (unsigned)(nconv < 512 ? nconv : 512), nc3 = 3u * ncp, qend = 1024u + (unsigned)nconv;
        for (;;) {
            if (tid == 0) *qslot = __hip_atomic_fetch_add((unsigned*)(ctl + CW_QUEUE + 128 * rep_), 1u, __ATOMIC_RELAXED, __HIP_MEMORY_SCOPE_AGENT);
            __syncthreads();
            const unsigned idx = (unsigned)__builtin_amdgcn_readfirstlane((int)*qslot);
            __syncthreads();
            if (idx >= qend) break;
            int cu = -1, a = -1;
            if (idx < nc3) { const unsigned p3 = idx / 3u, r3 = idx - 3u * p3; if (r3 == 2u) cu = (int)p3; else a = (int)(2u * p3 + r3); }
            else if (nconv <= 512) a = (int)(idx - (unsigned)nconv);
            else cu = (int)(idx - 1024u);
            if (cu >= 0) {
                if (PROBE_DUP != 4 || rep_ == 0) {
                    const DecB db{ConvB{w_up_nsa, w_up_fox, w_out, w_ff1, w_ff2, WUPA_T, WUPB_T, WOUT_T, WFF1_T, WFF2_T, cbv}};
                    const int laneC = fresh_lane(); LAS float* scr = (LAS float*)(lds + wave * (64 * 65 * 4));
                    const int i0 = nbt + cu * 64, e0 = i0 + 64; LAS float* shl = (LAS float*)(lds + 8 * (64 * 65 * 4));
                    const bool ff1u = i0 >= TI_FF1_0;
                    if (ff1u) { const int tC = wave * 64 + laneC; if (tC < 256) shl[tC] = mod[(size_t)(tC >> 6) * 24576 + 3 * DM + 64 * ((i0 - TI_FF1_0) / 256) + (tC & 63)]; __syncthreads(); }
                    tr_run(db, i0 + wave, 8, e0 < TI_B ? e0 : TI_B, scr, laneC, ff1u ? shl : (LAS float*)nullptr);
                }
            } else {
                const int k = a >> 1;
                if ((a & 1) == 0) { const int laneA = fresh_lane(), tidA = wave * 64 + laneA; const int u = 31 - (k >> 4), bg = k & 15;
                    att::nsa_unit(lds, bg >> 2, bg & 3, u, proj, small, kcmp, vcmp, nsa_q_norm, rope, onsa, tidA, wave, laneA); }
                else { const int laneB = fresh_lane(), tidB = wave * 64 + laneB; const int qb = 7 - (k >> 6), bh = k & 63;
                    att::fox_unit(lds, bh >> 4, bh & 15, qb, proj, cum, fox_q_norm, fox_k_norm, ofox, tidB, wave, laneB); }
            }
            __syncthreads();
        }
    REP_SEAM(4); }
    SEAM(4);
    if (IN(5)) REPS(5) { FRESH();
        static_assert(WS_OFOX == WS_ONSA + (size_t)M * 2048 * 2 && WS_WUPB_T == WS_WUPA_T + (size_t)DM * 2048 * 2, "the stacked operands are contiguous");
        pg8::UpOrder S; S.base.init(M, DM, G, bx);
        pg8::Gemm g{onsa, WUPA_T, 2 * M, 2 * DM, 2048}; pg8::EpiUpCat E{proj, Y};
        pg8::gemm_phase<pg8::EpiUpCat, pg8::UpOrder, true, true>(lds, g, S, E, tid);
    REP_SEAM(5); }
    SEAM(5);
    if (IN(6)) REPS(6) { FRESH();
        pg8::Gemm g{Y, WOUT_T, M, DM, DM}; pg8::StaticOrder S; S.init(M, DM, G, bx);
        pg8::EpiResNormF E{x, mod + 2 * DM, out, norm2_g, mod + 4 * DM, H, ssq};
        pg8::gemm_phase<pg8::EpiResNormF, pg8::StaticOrder, true, true>(lds, g, S, E, tid);
    REP_SEAM(6); }
    SEAM(6);
    if (IN(8)) REPS(8) { FRESH();
        pg8::Gemm g{H, WFF1_T, M, DFF, DM}; pg8::StaticOrder S; S.init(M, DFF, G, bx);
        pg8::EpiFF1NF E{Abuf, ssq, cbv};
        pg8::gemm_phase<pg8::EpiFF1NF, pg8::StaticOrder, true, true>(lds, g, S, E, tid);
    REP_SEAM(8); }
    SEAM(8);
    if (IN(9)) { FRESH();
        pg8::Gemm g{Abuf, WFF2_T, M, DM, DFF}; pg8::StaticOrder S; S.init(M, DM, G, bx);
        pg8::EpiResF E{out, mod + 5 * DM, out};
        pg8::gemm_phase<pg8::EpiResF, pg8::StaticOrder, true, true>(lds, g, S, E, tid);
    }
#undef IN
#undef SEAM
}

extern "C" void kernel_launch(void* const* d_in, const int* in_sizes, int n_in, void* d_out, int out_size, void* d_ws, size_t ws_size, hipStream_t stream) {
    static int grid = 0;
    if (grid == 0) {
        if (n_in != 23 || out_size != M * DM || ws_size < WS_END) { fprintf(stderr, "kernel_launch: unexpected shapes (n_in %d out %d ws %zu)\n", n_in, out_size, ws_size); grid = -1; return; }
        int dev = 0, cus = 0, per_cu = 0;
        if (hipGetDevice(&dev) != hipSuccess || hipDeviceGetAttribute(&cus, hipDeviceAttributeMultiprocessorCount, dev) != hipSuccess) { grid = -1; return; }
        if (hipFuncSetAttribute((const void*)mega_fwd, hipFuncAttributeMaxDynamicSharedMemorySize, LDS_BYTES) != hipSuccess) { fprintf(stderr, "kernel_launch: hipFuncSetAttribute failed\n"); grid = -1; return; }
        if (hipOccupancyMaxActiveBlocksPerMultiprocessor(&per_cu, (const void*)mega_fwd, NWAVES * 64, LDS_BYTES) != hipSuccess || per_cu < 1) fprintf(stderr, "kernel_launch: occupancy query says %d\n", per_cu);
        (void)hipGetLastError();
        grid = cus;
    }
    if (grid < 0) return;
    const float* x = (const float*)d_in[0];
    const float* b_forget = (const float*)d_in[7];
    const float* nsa_q_norm = (const float*)d_in[8]; const float* nsa_k_norm = (const float*)d_in[9]; const float* fox_q_norm = (const float*)d_in[10]; const float* fox_k_norm = (const float*)d_in[11];
    const float* w_cmp_k1 = (const float*)d_in[14]; const float* w_cmp_k2 = (const float*)d_in[15];
    const float* w_cmp_v1 = (const float*)d_in[16]; const float* w_cmp_v2 = (const float*)d_in[17];
    unsigned char* ws = (unsigned char*)d_ws; (void)x;
    float* c1 = (float*)(ws + WS_C1); float* rope = (float*)(ws + WS_ROPE); float* small = (float*)(ws + WS_SMALL); float* cum = (float*)(ws + WS_CUM);
    bf16_t* kcmp = (bf16_t*)(ws + WS_KCMP); bf16_t* vcmp = (bf16_t*)(ws + WS_VCMP); bf16_t* onsa = (bf16_t*)(ws + WS_ONSA); bf16_t* ofox = (bf16_t*)(ws + WS_OFOX);
    bf16_t* proj = (bf16_t*)(ws + WS_PROJ);

    (void)hipMemsetAsync(ws + WS_CTL, 0, WS_ZERO_BYTES, stream);
    Args a{};
    for (int i = 0; i < 23; ++i) a.in[i] = (const float*)d_in[i];
    a.out = (float*)d_out; a.ws = ws;
    a.ph_lo = 0; a.ph_hi = 10; a.li = 0;
    hipLaunchKernelGGL(mega_fwd, dim3(grid), dim3(NWAVES * 64), LDS_BYTES, stream, a);
}
```
